# Optimizing an MI355X kernel written in HIP

```python
import math
import jax, jax.numpy as jnp
from jax import lax
import numpy as np

D_MODEL = 1024
BATCH = 8
SEQ = 2048
DEPTH = 4

GRID_W = 64
CTX_LEN = 256
EPS = 1e-6
N_MOD = 9
DN_HEADS = 4
DN_HEAD_DIM = 128
DN_WIDTH = DN_HEADS * DN_HEAD_DIM
CONV_WIDTH = 3
DN_CHUNK = 64
DIFF_HEADS = 4
DIFF_QK_DIM = 64
DIFF_V_DIM = 2 * DIFF_QK_DIM
DIFF_WIDTH = DIFF_HEADS * DIFF_V_DIM
Q_BLOCK = 128
ROPE_BASE = 10000.0
RET_HEADS = 8
RET_KEY_DIM = D_MODEL // RET_HEADS
RET_VALUE_DIM = 2 * RET_KEY_DIM
RET_V_WIDTH = RET_HEADS * RET_VALUE_DIM
RET_CHUNK = 64
D_FF = 2816
N_AB_LAYERS = (DEPTH + 1) // 2
N_RET_LAYERS = DEPTH // 2
AB_SIZES = [DN_WIDTH] * 4 + [2 * DN_HEADS] * 2 + [DIFF_WIDTH] * 3
AB_IN = sum(AB_SIZES)
RET_SIZES = [RET_HEADS * RET_KEY_DIM] * 2 + [RET_V_WIDTH] * 2
RET_IN = sum(RET_SIZES)

kernel_name = "hybrid_deltanet_diffattn_retention_macaron_dit"

F32 = jnp.float32


def rms_norm(x, w=None):
    xf = x.astype(F32)
    y = xf * lax.rsqrt(jnp.mean(xf * xf, axis=-1, keepdims=True) + EPS)
    if w is not None:
        y = y * w.astype(F32)
    return y.astype(x.dtype)


def l2norm(t):
    return t * lax.rsqrt(jnp.sum(t * t, axis=-1, keepdims=True) + EPS)


def split_cols(p, sizes):
    return jnp.split(p, [int(s) for s in np.cumsum(sizes)[:-1]], axis=-1)


def to_heads(t, n):
    B, L, _ = t.shape
    return t.reshape(B, L, n, -1).transpose(0, 2, 1, 3)


def ada_in(x, g, m, s):
    return rms_norm(x, g) * (1 + m[:, 3 * s + 1][:, None, :]) + m[:, 3 * s][:, None, :]


def ada_gate(m, s):
    return m[:, 3 * s + 2][:, None, :]


def swiglu(h, w_in, w_out):
    g, u = jnp.split(h @ w_in, 2, axis=-1)
    return (jax.nn.silu(g) * u) @ w_out


def rotate_half(x):
    x1, x2 = jnp.split(x, 2, axis=-1)
    return jnp.concatenate([-x2, x1], axis=-1)


def rope(x, ang):
    cos = jnp.concatenate([jnp.cos(ang)] * 2, axis=-1)
    sin = jnp.concatenate([jnp.sin(ang)] * 2, axis=-1)
    return x * cos + rotate_half(x) * sin


def axial_angles(L):
    rows = L // GRID_W
    r, cidx = jnp.meshgrid(jnp.arange(rows), jnp.arange(GRID_W), indexing='ij')
    axis_dim = DIFF_QK_DIM // 2
    inv = ROPE_BASE ** (-jnp.arange(0, axis_dim, 2, dtype=F32) / axis_dim)
    return (r.reshape(-1).astype(F32)[:, None] * inv, cidx.reshape(-1).astype(F32)[:, None] * inv)


def axial_rope(x, ang_r, ang_c):
    xr, xc = jnp.split(x, 2, axis=-1)
    return jnp.concatenate([rope(xr, ang_r), rope(xc, ang_c)], axis=-1)


def short_conv(u, w):
    k = w.shape[0]
    return lax.conv_general_dilated(u, w.astype(u.dtype)[:, None, :], window_strides=(1,),
                                    padding=[(k // 2, k // 2)],
                                    dimension_numbers=('NWC', 'WIO', 'NWC'),
                                    feature_group_count=u.shape[-1])


def two_pass(fn, ctx_seqs, lat_seqs, S0):
    outs_c, outs_l = [], []
    for d in range(2):
        f = (lambda t: jnp.flip(t, 2)) if d == 1 else (lambda t: t)
        oc, S = fn(d, [f(t) for t in ctx_seqs], S0)
        ol, _ = fn(d, [f(t) for t in lat_seqs], S)
        outs_c.append(f(oc))
        outs_l.append(f(ol))
    return outs_c[0] + outs_c[1], outs_l[0] + outs_l[1]


def gated_delta_chunked(q, k, v, log_a, beta, S0):
    B, H, L, _ = q.shape
    dv = v.shape[-1]
    C = DN_CHUNK
    n = L // C
    q, k, v = (t.reshape(B, H, n, C, t.shape[-1]) for t in (q, k, v))
    log_a, beta = (t.reshape(B, H, n, C) for t in (log_a, beta))
    g = jnp.cumsum(log_a, axis=-1)
    tril = jnp.tril(jnp.ones((C, C), bool))
    strict = jnp.tril(jnp.ones((C, C), bool), -1)
    gamma = jnp.exp(jnp.where(tril, g[..., :, None] - g[..., None, :], -jnp.inf))
    kb = k * beta[..., None]
    lower = jnp.where(strict, jnp.einsum('bhnid,bhnjd->bhnij', kb, k) * gamma, 0.0)
    tmat = lower + jnp.eye(C, dtype=lower.dtype)
    solve = lambda rhs: lax.linalg.triangular_solve(tmat, rhs, left_side=True, lower=True,
                                                    unit_diagonal=True)
    u = solve(v * beta[..., None])
    w = solve(kb * jnp.exp(g)[..., None])
    qk = jnp.einsum('bhnid,bhnjd->bhnij', q, k) * gamma

    def step(S, inp):
        q_i, k_i, u_i, w_i, g_i, qk_i = inp
        v_new = u_i - jnp.einsum('bhcd,bhde->bhce', w_i, S)
        o = (jnp.einsum('bhcd,bhde->bhce', q_i * jnp.exp(g_i)[..., None], S)
             + jnp.einsum('bhij,bhje->bhie', qk_i, v_new))
        g_last = g_i[..., -1:]
        S = (S * jnp.exp(g_last)[..., None]
             + jnp.einsum('bhcd,bhce->bhde', k_i * jnp.exp(g_last - g_i)[..., None], v_new))
        return S, o

    xs = tuple(jnp.moveaxis(t, 2, 0) for t in (q, k, u, w, g, qk))
    S, o = lax.scan(step, S0, xs)
    return jnp.moveaxis(o, 0, 2).reshape(B, H, L, dv), S


def retention_chunked(q, k, v, log_gamma, S0):
    B, H, L, _ = q.shape
    dv = v.shape[-1]
    C = RET_CHUNK
    n = L // C
    q, k, v = (t.reshape(B, H, n, C, t.shape[-1]) for t in (q, k, v))
    pos = jnp.arange(C, dtype=F32)
    lg = log_gamma[:, None]
    tril = jnp.tril(jnp.ones((C, C), bool))
    dec = jnp.exp(jnp.where(tril, (pos[:, None] - pos[None, :]) * lg[:, :, None], -jnp.inf))
    o_inner = jnp.einsum('bhnij,bhnje->bhnie',
                         jnp.einsum('bhnid,bhnjd->bhnij', q, k) * dec[:, None], v)
    q_dec = jnp.exp(lg * (pos + 1))[:, :, None]
    k_dec = jnp.exp(lg * (C - 1 - pos))[:, :, None]
    c_dec = jnp.exp(log_gamma * C)[:, None, None]

    def step(S, inp):
        q_i, k_i, v_i, o_i = inp
        o = o_i + jnp.einsum('bhcd,bhde->bhce', q_i, S) * q_dec
        S = S * c_dec + jnp.einsum('bhcd,bhce->bhde', k_i * k_dec, v_i)
        return S, o

    xs = tuple(jnp.moveaxis(t, 2, 0) for t in (q, k, v, o_inner))
    S, o = lax.scan(step, S0, xs)
    return jnp.moveaxis(o, 0, 2).reshape(B, H, L, dv), S


def diff_attend(q, k, v, lam_full):
    s = jnp.einsum('bhmqd,bhmkd->bhmqk', q, k) * DIFF_QK_DIM ** -0.5
    p = jax.nn.softmax(s, axis=-1)
    return jnp.einsum('bhqk,bhkd->bhqd', p[:, :, 0] - lam_full * p[:, :, 1], v)


def ab_mixer(hc, hl, w_in, conv_w, A_log, dt_bias, dn_norm_w, lam, subln_w, w_out,
             layer_idx, with_ctx_out):
    pc = split_cols(hc @ w_in, AB_SIZES)
    pl = split_cols(hl @ w_in, AB_SIZES)
    B, L, _ = hl.shape
    A_log = A_log.astype(F32)
    dt_bias = dt_bias.astype(F32)

    def dn_seqs(p):
        q, k, v, _, a, b = p[:6]
        qkv = jax.nn.silu(short_conv(jnp.concatenate([q, k, v], axis=-1), conv_w)).astype(F32)
        q, k, v = (to_heads(t, DN_HEADS) for t in jnp.split(qkv, 3, axis=-1))
        q = l2norm(q) * DN_HEAD_DIM ** -0.5
        k = l2norm(k)
        Bs, Ls, _ = a.shape
        a = a.astype(F32).reshape(Bs, Ls, 2, DN_HEADS)
        b = b.astype(F32).reshape(Bs, Ls, 2, DN_HEADS)
        log_a = (-jnp.exp(A_log) * jax.nn.softplus(a + dt_bias)).transpose(0, 3, 1, 2)
        beta = jax.nn.sigmoid(b).transpose(0, 3, 1, 2)
        return [q, k, v, log_a, beta]

    S0 = jnp.zeros((B, DN_HEADS, DN_HEAD_DIM, DN_HEAD_DIM), F32)
    dn_fn = lambda d, s, S: gated_delta_chunked(s[0], s[1], s[2], s[3][..., d], s[4][..., d], S)
    dn_c, dn_l = two_pass(dn_fn, dn_seqs(pc), dn_seqs(pl), S0)

    def dn_merge(o, z):
        Bs, H, Ls, dv = o.shape
        y = rms_norm(o.transpose(0, 2, 1, 3), dn_norm_w) * jax.nn.silu(z.astype(F32)).reshape(Bs, Ls, H, dv)
        return y.reshape(Bs, Ls, H * dv)

    lambda_init = 0.8 - 0.6 * math.exp(-0.3 * layer_idx)
    lamf = lam.astype(F32)
    lam_full = jnp.exp(jnp.sum(lamf[0] * lamf[1])) - jnp.exp(jnp.sum(lamf[2] * lamf[3])) + lambda_init

    def diff_qkv(p):
        q, k, v = p[6:]
        Bs, Ls, _ = q.shape
        q, k = (t.astype(F32).reshape(Bs, Ls, DIFF_HEADS, 2, DIFF_QK_DIM).transpose(0, 2, 3, 1, 4)
                for t in (q, k))
        return q, k, to_heads(v, DIFF_HEADS).astype(F32)

    def diff_merge(o):
        Bs, H, Ls, dv = o.shape
        return (rms_norm(o, subln_w) * (1 - lambda_init)).transpose(0, 2, 1, 3).reshape(Bs, Ls, H * dv)

    qc, kc, vc = diff_qkv(pc)
    ql, kl, vl = diff_qkv(pl)
    ang_r, ang_c = axial_angles(L)
    ql, kl = axial_rope(ql, ang_r, ang_c), axial_rope(kl, ang_r, ang_c)
    k_all = jnp.concatenate([kc, kl], axis=3)
    v_all = jnp.concatenate([vc, vl], axis=2)
    nb = L // Q_BLOCK
    qb = jnp.moveaxis(ql.reshape(B, DIFF_HEADS, 2, nb, Q_BLOCK, DIFF_QK_DIM), 3, 0)
    ol = lax.map(lambda qi: diff_attend(qi, k_all, v_all, lam_full), qb)
    ol = jnp.moveaxis(ol, 0, 2).reshape(B, DIFF_HEADS, L, DIFF_V_DIM)

    y_l = jnp.concatenate([dn_merge(dn_l, pl[3]), diff_merge(ol)], axis=-1).astype(hl.dtype) @ w_out
    if not with_ctx_out:
        return None, y_l
    oc = diff_attend(qc, kc, vc, lam_full)
    y_c = jnp.concatenate([dn_merge(dn_c, pc[3]), diff_merge(oc)], axis=-1).astype(hc.dtype) @ w_out
    return y_c, y_l


def ret_mixer(hc, hl, w_in, decay_logit, w_out, with_ctx_out):
    def stream(h, rotate):
        q, k, v, g = split_cols(h @ w_in, RET_SIZES)
        q, k, v = (to_heads(t, RET_HEADS).astype(F32) for t in (q, k, v))
        if rotate:
            inv = ROPE_BASE ** (-jnp.linspace(0.0, 1.0, RET_KEY_DIM // 2, dtype=F32))
            ang = jnp.arange(h.shape[1], dtype=F32)[:, None] * inv
            q, k = rope(q, ang), rope(k, ang)
        return [q, k * RET_KEY_DIM ** -0.5, v], g

    sc, gc = stream(hc, False)
    sl, gl = stream(hl, True)
    log_gamma = jax.nn.log_sigmoid(decay_logit.astype(F32))
    S0 = jnp.zeros((hl.shape[0], RET_HEADS, RET_KEY_DIM, RET_VALUE_DIM), F32)
    ret_fn = lambda d, s, S: retention_chunked(s[0], s[1], s[2], log_gamma[d], S)
    oc, ol = two_pass(ret_fn, sc, sl, S0)

    def merge(o, g, dtype):
        Bs, H, Ls, dv = o.shape
        y = rms_norm(o.transpose(0, 2, 1, 3)).reshape(Bs, Ls, H * dv) * jax.nn.silu(g.astype(F32))
        return y.astype(dtype) @ w_out

    y_l = merge(ol, gl, hl.dtype)
    if not with_ctx_out:
        return None, y_l
    return merge(oc, gc, hc.dtype), y_l


def setup_inputs(seed: int = 0) -> dict:
    key = jax.random.key(seed)
    ks = jax.random.split(key, 24)
    nrm = lambda k, shape, s: jax.random.normal(k, shape, F32) * s
    x = nrm(ks[0], (BATCH, SEQ, D_MODEL), 1.0)
    c = nrm(ks[1], (BATCH, D_MODEL), 1.0)
    ctx = nrm(ks[2], (BATCH, CTX_LEN, D_MODEL), 1.0)
    c_ctx = nrm(ks[3], (D_MODEL,), 1.0)
    ada_w = nrm(ks[4], (DEPTH, D_MODEL, N_MOD * D_MODEL), D_MODEL ** -0.5)
    ada_b = nrm(ks[5], (DEPTH, N_MOD * D_MODEL), 0.01)
    norm_w = 1.0 + nrm(ks[6], (DEPTH, 3, D_MODEL), 0.02)
    final_norm_w = 1.0 + nrm(ks[7], (D_MODEL,), 0.02)
    ffn_w_in = nrm(ks[8], (DEPTH, 2, D_MODEL, 2 * D_FF), D_MODEL ** -0.5)
    ffn_w_out = nrm(ks[9], (DEPTH, 2, D_FF, D_MODEL), D_FF ** -0.5)
    ab_w_in = nrm(ks[10], (N_AB_LAYERS, D_MODEL, AB_IN), D_MODEL ** -0.5)
    ab_conv_w = nrm(ks[11], (N_AB_LAYERS, CONV_WIDTH, 3 * DN_WIDTH), CONV_WIDTH ** -0.5)
    dn_A_log = jnp.log(jax.random.uniform(ks[12], (N_AB_LAYERS, 2, DN_HEADS), F32, 1.0, 16.0))
    dt = jnp.exp(jax.random.uniform(ks[13], (N_AB_LAYERS, 2, DN_HEADS), F32,
                                    math.log(1e-3), math.log(1e-1)))
    dn_dt_bias = dt + jnp.log(-jnp.expm1(-dt))
    dn_norm_w = 1.0 + nrm(ks[14], (N_AB_LAYERS, DN_HEAD_DIM), 0.02)
    diff_lambda = nrm(ks[15], (N_AB_LAYERS, 4, DIFF_QK_DIM), 0.1)
    diff_subln_w = 1.0 + nrm(ks[16], (N_AB_LAYERS, DIFF_V_DIM), 0.02)
    ab_w_out = nrm(ks[17], (N_AB_LAYERS, DN_WIDTH + DIFF_WIDTH, D_MODEL), (DN_WIDTH + DIFF_WIDTH) ** -0.5)
    ret_w_in = nrm(ks[18], (N_RET_LAYERS, D_MODEL, RET_IN), D_MODEL ** -0.5)
    base_logit = jnp.asarray(np.log(2.0 ** (5.0 + np.arange(RET_HEADS)) - 1.0).astype(np.float32))
    ret_decay_logit = base_logit + nrm(ks[19], (N_RET_LAYERS, 2, RET_HEADS), 0.1)
    ret_w_out = nrm(ks[20], (N_RET_LAYERS, RET_V_WIDTH, D_MODEL), RET_V_WIDTH ** -0.5)
    return {"x": x, "c": c, "ctx": ctx, "c_ctx": c_ctx, "ada_w": ada_w, "ada_b": ada_b,
            "norm_w": norm_w, "final_norm_w": final_norm_w, "ffn_w_in": ffn_w_in,
            "ffn_w_out": ffn_w_out, "ab_w_in": ab_w_in, "ab_conv_w": ab_conv_w,
            "dn_A_log": dn_A_log, "dn_dt_bias": dn_dt_bias, "dn_norm_w": dn_norm_w,
            "diff_lambda": diff_lambda, "diff_subln_w": diff_subln_w, "ab_w_out": ab_w_out,
            "ret_w_in": ret_w_in, "ret_decay_logit": ret_decay_logit, "ret_w_out": ret_w_out}


def reference(x, c, ctx, c_ctx, ada_w, ada_b, norm_w, final_norm_w, ffn_w_in, ffn_w_out,
              ab_w_in, ab_conv_w, dn_A_log, dn_dt_bias, dn_norm_w, diff_lambda, diff_subln_w,
              ab_w_out, ret_w_in, ret_decay_logit, ret_w_out):
    xc = ctx
    s_lat = jax.nn.silu(c)
    s_ctx = jax.nn.silu(c_ctx)[None]
    for l in range(DEPTH):
        last = l == DEPTH - 1
        m_lat = (s_lat @ ada_w[l] + ada_b[l]).reshape(-1, N_MOD, D_MODEL)
        m_ctx = (s_ctx @ ada_w[l] + ada_b[l]).reshape(1, N_MOD, D_MODEL)
        x = x + 0.5 * ada_gate(m_lat, 0) * swiglu(ada_in(x, norm_w[l, 0], m_lat, 0), ffn_w_in[l, 0], ffn_w_out[l, 0])
        xc = xc + 0.5 * ada_gate(m_ctx, 0) * swiglu(ada_in(xc, norm_w[l, 0], m_ctx, 0), ffn_w_in[l, 0], ffn_w_out[l, 0])
        hl = ada_in(x, norm_w[l, 1], m_lat, 1)
        hc = ada_in(xc, norm_w[l, 1], m_ctx, 1)
        i = l // 2
        if l % 2 == 0:
            yc, yl = ab_mixer(hc, hl, ab_w_in[i], ab_conv_w[i], dn_A_log[i], dn_dt_bias[i],
                              dn_norm_w[i], diff_lambda[i], diff_subln_w[i], ab_w_out[i],
                              l, not last)
        else:
            yc, yl = ret_mixer(hc, hl, ret_w_in[i], ret_decay_logit[i], ret_w_out[i], not last)
        x = x + ada_gate(m_lat, 1) * yl
        x = x + 0.5 * ada_gate(m_lat, 2) * swiglu(ada_in(x, norm_w[l, 2], m_lat, 2), ffn_w_in[l, 1], ffn_w_out[l, 1])
        if not last:
            xc = xc + ada_gate(m_ctx, 1) * yc
            xc = xc + 0.5 * ada_gate(m_ctx, 2) * swiglu(ada_in(xc, norm_w[l, 2], m_ctx, 2), ffn_w_in[l, 1], ffn_w_out[l, 1])
    return rms_norm(x, final_norm_w)
```

```cpp
#include <hip/hip_runtime.h>
#include <hip/hip_cooperative_groups.h>
#include <cstdio>
#include <cstdint>
namespace cg = cooperative_groups;

__device__ __forceinline__ int opaque_tid() { int t = threadIdx.x; asm volatile("" : "+v"(t)); return t; }
__device__ __forceinline__ int bid() { int b = blockIdx.x; asm volatile("" : "+s"(b)); return b; }
__device__ __forceinline__ int gdim() { int g = gridDim.x; asm volatile("" : "+s"(g)); return g; }
namespace pg8 {
#define PG8_LAS __attribute__((address_space(3)))
typedef unsigned short bf16_t;
typedef short bf16x8 __attribute__((ext_vector_type(8)));
typedef float f32x4 __attribute__((ext_vector_type(4)));
typedef unsigned u32x4 __attribute__((ext_vector_type(4)));
constexpr int BM = 256, BK = 64, HALF = 128, HTB = HALF * BK * 2  , STAGE_BYTES = 8 * HTB, NXCD = 8, WGM = 4;
__host__ __device__ __forceinline__ int lds_byte(int r, int c) { const int st = (r >> 4) * 2 + (c >> 5), rr = r & 15, cc = c & 31, ob = rr * 64 + cc * 2; return st * 1024 + (ob ^ (((ob >> 9) & 1) << 5)); }
__host__ __device__ __forceinline__ void stage_rc(int b, int& R, int& C) { const int st = b / 1024, sb = b % 1024, swz = sb ^ (((sb >> 9) & 1) << 5); R = (st >> 1) * 16 + swz / 64; C = (st & 1) * 32 + (swz % 64) / 2; }
__host__ __device__ __forceinline__ int perm32(int rho) { const int n = rho >> 4, i = rho & 15; return 8 * (i >> 2) + 4 * n + (i & 3); }

struct Unit { int pm, pn; };
struct Gemm { const bf16_t* A; const bf16_t* Bt; int M, N, K; };

struct StaticOrder {
    int nM, nN, nwg, G, c;
    __host__ __device__ void init(int M, int N, int G_, int c_) { nM = M / BM; nN = N / BM; nwg = nM * nN; G = G_; c = c_; }
    __host__ __device__ bool next(int i, Unit& u) const {
        const long L = (long)i * G + c; if (L >= nwg) return false;
        int wgid = (int)L; { const int q = nwg / NXCD, r = nwg % NXCD, xcd = wgid % NXCD, off = wgid / NXCD; wgid = (xcd < r ? xcd * (q + 1) : r * (q + 1) + (xcd - r) * q) + off; }
        const int nig = WGM * nN, gid = wgid / nig, fm = gid * WGM, gsz = (nM - fm) < WGM ? (nM - fm) : WGM;
        u.pm = fm + ((wgid % nig) % gsz); u.pn = (wgid % nig) / gsz; return true;
    }
    __device__ __forceinline__ void a_ready(const Unit&) const {}
    __device__ __forceinline__ void done(const Unit&) const {}
};

__device__ __forceinline__ unsigned cvt_pk_bf16(float lo, float hi) { unsigned r; asm volatile("v_cvt_pk_bf16_f32 %0, %1, %2" : "=v"(r) : "v"(lo), "v"(hi)); return r; }

__device__ __forceinline__ float fast_silu(float g) { return g * __builtin_amdgcn_rcpf(1.0f + __expf(-g)); }

struct EpiSwiglu {
    static constexpr bool PERM = true, AFTER_DRAIN = false;
    bf16_t* O; int ldc; bf16_t* OC;
    __device__ __forceinline__ void operator()(const f32x4 (&acc)[2][2][4][2], const Unit& u, int wr, int wc, int fr, int fq) const {
        const int row0 = u.pm * BM + wr * 64 + fr, col0 = u.pn * HALF + wc * 32 + 8 * fq;
        bf16_t* base = O + (size_t)row0 * ldc + col0; size_t pitch = (size_t)ldc;
        if (OC && u.pm >= 64) { const int kh = col0 >= 1408 ? 1 : 0; base = OC + ((size_t)kh * 2048 + (row0 - 16384)) * 1408 + (col0 - kh * 1408); pitch = 1408; }
#pragma unroll
        for (int ai = 0; ai < 2; ++ai)
#pragma unroll
            for (int m = 0; m < 4; ++m) { bf16_t* rowp = base + (size_t)(ai * HALF + m * 16) * pitch;
                const f32x4 g0 = acc[ai][0][m][0], g1 = acc[ai][0][m][1], u0 = acc[ai][1][m][0], u1 = acc[ai][1][m][1];
                float h[8];
#pragma unroll
                for (int j = 0; j < 4; ++j) { h[j] = fast_silu(g0[j]) * u0[j]; h[4 + j] = fast_silu(g1[j]) * u1[j]; }
                u32x4 w; w.x = cvt_pk_bf16(h[0], h[1]); w.y = cvt_pk_bf16(h[2], h[3]); w.z = cvt_pk_bf16(h[4], h[5]); w.w = cvt_pk_bf16(h[6], h[7]);
                *(u32x4*)rowp = w; }
    }
};
struct CtxSplitOrder {
    int G, c;
    __device__ bool next(int i, Unit& u) const { const int L = i * G + c; if (L >= 64) return false; const int kh = L >> 5, r = L & 31; u.pm = kh * 8 + (r >> 2); u.pn = kh * 4 + (r & 3); return true; }
    __device__ __forceinline__ void a_ready(const Unit&) const {}
    __device__ __forceinline__ void done(const Unit&) const {}
};
struct EpiPartial {
    static constexpr bool PERM = false, AFTER_DRAIN = false;
    float* P;
    __device__ __forceinline__ void operator()(const f32x4 (&acc)[2][2][4][2], const Unit& u, int wr, int wc, int fr, int fq) const {
        const int kh = u.pn >> 2, row0 = (u.pm & 7) * BM + wr * 64 + fr, col0 = (u.pn & 3) * BM + wc * 32 + 4 * fq;
        float* base = P + ((size_t)kh * 2048 + row0) * 1024 + col0;
#pragma unroll
        for (int ai = 0; ai < 2; ++ai)
#pragma unroll
            for (int m = 0; m < 4; ++m)
#pragma unroll
                for (int bj = 0; bj < 2; ++bj)
#pragma unroll
                    for (int n = 0; n < 2; ++n) *(f32x4*)(base + (size_t)(ai * HALF + m * 16) * 1024 + bj * HALF + n * 16) = acc[ai][bj][m][n];
    }
};
struct EpiResid {
    static constexpr bool PERM = false, AFTER_DRAIN = false;
    const float* xin_lat; const float* xin_ctx; float* xout; const float* gate; float s;
    __device__ __forceinline__ void operator()(const f32x4 (&acc)[2][2][4][2], const Unit& u, int wr, int wc, int fr, int fq) const {
        const int row0 = u.pm * BM + wr * 64 + fr, col0 = u.pn * BM + wc * 32 + 4 * fq;
        const int mr = u.pm < 64 ? (u.pm >> 3) : 8;
        f32x4 gv[2][2];
#pragma unroll
        for (int bj = 0; bj < 2; ++bj)
#pragma unroll
            for (int n = 0; n < 2; ++n) gv[bj][n] = *(const f32x4*)(gate + (size_t)mr * 9216 + col0 + bj * HALF + n * 16) * s;
#pragma unroll
        for (int ai = 0; ai < 2; ++ai) {
            f32x4 xv[4][2][2];
#pragma unroll
            for (int m = 0; m < 4; ++m) { const int row = row0 + ai * HALF + m * 16;
                const float* xi = row < 16384 ? xin_lat + (size_t)row * 1024 : xin_ctx + (size_t)(row - 16384) * 1024;
#pragma unroll
                for (int bj = 0; bj < 2; ++bj)
#pragma unroll
                    for (int n = 0; n < 2; ++n) xv[m][bj][n] = *(const f32x4*)(xi + col0 + bj * HALF + n * 16); }
            asm volatile("" ::: "memory");
#pragma unroll
            for (int m = 0; m < 4; ++m) { float* xo = xout + (size_t)(row0 + ai * HALF + m * 16) * 1024;
#pragma unroll
                for (int bj = 0; bj < 2; ++bj)
#pragma unroll
                    for (int n = 0; n < 2; ++n) *(f32x4*)(xo + col0 + bj * HALF + n * 16) = xv[m][bj][n] + gv[bj][n] * acc[ai][bj][m][n]; }
            asm volatile("" ::: "memory");
        }
    }
};
struct EpiBf16 {
    static constexpr bool PERM = true, AFTER_DRAIN = false;
    bf16_t* O; int ldc; int split_cols; size_t split_stride;
    __device__ __forceinline__ void operator()(const f32x4 (&acc)[2][2][4][2], const Unit& u, int wr, int wc, int fr, int fq) const {
        const int row0 = u.pm * BM + wr * 64 + fr; int colt = u.pn * BM; bf16_t* base = O;
        if (split_cols) { const int t = colt / split_cols; base += (size_t)t * split_stride; colt -= t * split_cols; }
        const int col0 = colt + wc * 32 + 8 * fq;
#pragma unroll
        for (int ai = 0; ai < 2; ++ai)
#pragma unroll
            for (int m = 0; m < 4; ++m) { bf16_t* rowp = base + (size_t)(row0 + ai * HALF + m * 16) * ldc + col0;
#pragma unroll
                for (int bj = 0; bj < 2; ++bj) { const f32x4 v0 = acc[ai][bj][m][0], v1 = acc[ai][bj][m][1];
                    u32x4 w; w.x = cvt_pk_bf16(v0[0], v0[1]); w.y = cvt_pk_bf16(v0[2], v0[3]); w.z = cvt_pk_bf16(v1[0], v1[1]); w.w = cvt_pk_bf16(v1[2], v1[3]);
                    *(u32x4*)(rowp + bj * HALF) = w; } }
    }
};

typedef PG8_LAS unsigned char* pg8_lds_t_;
template <class Epi, class Sched, bool ALIGN_EPI = false, bool SP2 = false>
__device__ __forceinline__ void gemm_phase(PG8_LAS unsigned char* lds, const Gemm g, const Sched& S, const Epi& E) {
    const int tid = opaque_tid(), wid = __builtin_amdgcn_readfirstlane(tid >> 6), lane = tid & 63, wr = wid >> 2, wc = wid & 3, fr = lane & 15, fq = lane >> 4;
    const int K = g.K, nt = K / BK;
    unsigned voffA[2], voffB[2];
#pragma unroll
    for (int i = 0; i < 2; ++i) { int R, C; stage_rc(tid * 16 + i * 8192, R, C); const int Rb = Epi::PERM ? ((R & ~31) + perm32(R & 31)) : R;
        voffA[i] = (unsigned)(R * K + C) * 2u; voffB[i] = (unsigned)(Rb * K + C) * 2u; }
    const size_t kstep = (size_t)(BK * 2);
    const size_t hstep = (size_t)HALF * K * 2;
    const size_t tstep = 2 * hstep;
    const unsigned ldsw = (unsigned)wid * 1024u;
    const int aoff = lds_byte(wr * 64 + fr, fq * 8), boff = lds_byte(wc * 32 + fr, fq * 8);
#define PG8_SA(b, h) (((b) * 2 + (h)) * HTB)
#define PG8_SB(b, h) ((4 + (b) * 2 + (h)) * HTB)
#define PG8_STAGE(bufoff, gbase, voff) do { _Pragma("unroll") for (int _i = 0; _i < 2; ++_i) \
        __builtin_amdgcn_global_load_lds((const unsigned*)((const char*)(gbase) + (voff)[_i]), (PG8_LAS unsigned*)(lds + (bufoff) + ldsw + _i * 8192), 16, 0, 0); } while (0)
#define PG8_LDA(dst, b, h) do { _Pragma("unroll") for (int m = 0; m < 4; ++m) _Pragma("unroll") for (int k = 0; k < 2; ++k) dst[m][k] = *(const PG8_LAS bf16x8*)(lds + PG8_SA(b, h) + aoff + m * 2048 + k * 1024); } while (0)
#define PG8_LDB(dst, b, h) do { _Pragma("unroll") for (int n = 0; n < 2; ++n) _Pragma("unroll") for (int k = 0; k < 2; ++k) dst[n][k] = *(const PG8_LAS bf16x8*)(lds + PG8_SB(b, h) + boff + n * 2048 + k * 1024); } while (0)
#define PG8_MMA(ai, bj, At, Bt) do { __builtin_amdgcn_s_setprio(1); _Pragma("unroll") for (int m = 0; m < 4; ++m) _Pragma("unroll") for (int n = 0; n < 2; ++n) _Pragma("unroll") for (int k = 0; k < 2; ++k) \
        acc[ai][bj][m][n] = __builtin_amdgcn_mfma_f32_16x16x32_bf16(Bt[n][k], At[m][k], acc[ai][bj][m][n], 0, 0, 0); __builtin_amdgcn_s_setprio(0); } while (0)
#define PG8_WAIT_V(n) asm volatile("s_waitcnt vmcnt(" #n ")" ::: "memory")
#define PG8_WAIT_L(n) asm volatile("s_waitcnt lgkmcnt(" #n ")" ::: "memory")
#define PG8_BAR __builtin_amdgcn_s_barrier()
#define PG8_SCHED __builtin_amdgcn_sched_barrier(0)
    Unit cur, nxt; int ui = 0;
    if (!S.next(0, cur)) return;
    f32x4 acc[2][2][4][2];
#pragma unroll
    for (int a = 0; a < 2; ++a)
#pragma unroll
        for (int b = 0; b < 2; ++b)
#pragma unroll
            for (int m = 0; m < 4; ++m)
#pragma unroll
                for (int n = 0; n < 2; ++n) acc[a][b][m][n] = (f32x4){0.f, 0.f, 0.f, 0.f};
    bf16x8 At[4][2], B0[2][2], B1[2][2];
    const char* cA = (const char*)g.A + (size_t)cur.pm * tstep; const char* cB = (const char*)g.Bt + (size_t)cur.pn * tstep;
    S.a_ready(cur);
    if constexpr (SP2) {
        PG8_STAGE(PG8_SB(0, 0), cB, voffB); PG8_STAGE(PG8_SB(0, 1), cB + hstep, voffB); PG8_STAGE(PG8_SA(0, 0), cA, voffA); PG8_STAGE(PG8_SA(0, 1), cA + hstep, voffA);
        if (wr == 1) PG8_BAR;
        PG8_WAIT_V(2); PG8_BAR;
        PG8_STAGE(PG8_SB(1, 0), cB + kstep, voffB); PG8_STAGE(PG8_SA(1, 0), cA + kstep, voffA); PG8_STAGE(PG8_SB(1, 1), cB + hstep + kstep, voffB);
        PG8_WAIT_V(6); PG8_BAR;
    } else {
        PG8_STAGE(PG8_SB(0, 0), cB, voffB); PG8_STAGE(PG8_SA(0, 0), cA, voffA); PG8_STAGE(PG8_SB(0, 1), cB + hstep, voffB); PG8_STAGE(PG8_SA(0, 1), cA + hstep, voffA);
        if (wr == 1) PG8_BAR;
        PG8_WAIT_V(4); PG8_BAR;
        PG8_STAGE(PG8_SB(1, 0), cB + kstep, voffB); PG8_STAGE(PG8_SA(1, 0), cA + kstep, voffA); PG8_STAGE(PG8_SB(1, 1), cB + hstep + kstep, voffB);
        PG8_WAIT_V(6); PG8_BAR;
    }
    for (;;) {
        const bool has_next = S.next(ui + 1, nxt);
        const char* nA = has_next ? (const char*)g.A + (size_t)nxt.pm * tstep : cA; const char* nB = has_next ? (const char*)g.Bt + (size_t)nxt.pn * tstep : cB;
        for (int t = 0; t < nt; t += 2) {
            const bool last = (t == nt - 2);
            const char* a1 = cA + (size_t)(t + 1) * kstep;
            const char* a2 = last ? nA : cA + (size_t)(t + 2) * kstep; const char* b2 = last ? nB : cB + (size_t)(t + 2) * kstep;
            const char* a3 = a2 + kstep; const char* b3 = b2 + kstep;
            if (last && has_next) S.a_ready(nxt);
            if constexpr (SP2) {
            PG8_LDB(B0, 0, 0); PG8_LDB(B1, 0, 1); PG8_SCHED; PG8_LDA(At, 0, 0); PG8_STAGE(PG8_SA(1, 1), a1 + hstep, voffA);
            PG8_WAIT_V(8); PG8_WAIT_L(0); PG8_BAR; PG8_MMA(0, 0, At, B0); PG8_MMA(0, 1, At, B1); PG8_BAR; PG8_SCHED;
            PG8_LDA(At, 0, 1); PG8_STAGE(PG8_SB(0, 0), b2, voffB); PG8_STAGE(PG8_SB(0, 1), b2 + hstep, voffB); PG8_STAGE(PG8_SA(0, 0), a2, voffA);
            PG8_WAIT_V(8); PG8_WAIT_L(0); PG8_BAR; PG8_MMA(1, 0, At, B0); PG8_MMA(1, 1, At, B1); PG8_BAR; PG8_SCHED;
            PG8_LDB(B0, 1, 0); PG8_LDB(B1, 1, 1); PG8_SCHED; PG8_LDA(At, 1, 0); PG8_STAGE(PG8_SA(0, 1), a2 + hstep, voffA);
            PG8_WAIT_V(8); PG8_WAIT_L(0); PG8_BAR; PG8_MMA(0, 0, At, B0); PG8_MMA(0, 1, At, B1); PG8_BAR; PG8_SCHED;
            PG8_LDA(At, 1, 1); PG8_STAGE(PG8_SB(1, 0), b3, voffB); PG8_STAGE(PG8_SB(1, 1), b3 + hstep, voffB); PG8_STAGE(PG8_SA(1, 0), a3, voffA);
            PG8_WAIT_V(8); PG8_WAIT_L(0); PG8_BAR; PG8_MMA(1, 0, At, B0); PG8_MMA(1, 1, At, B1); PG8_BAR; PG8_SCHED;
            } else {
            PG8_LDB(B0, 0, 0); PG8_SCHED; PG8_LDA(At, 0, 0); PG8_STAGE(PG8_SA(1, 1), a1 + hstep, voffA);
            PG8_WAIT_L(8); PG8_BAR; PG8_WAIT_L(0); PG8_MMA(0, 0, At, B0); PG8_BAR; PG8_SCHED;
            PG8_LDB(B1, 0, 1); PG8_STAGE(PG8_SB(0, 0), b2, voffB);
            PG8_BAR; PG8_WAIT_L(0); PG8_MMA(0, 1, At, B1); PG8_BAR;
            PG8_LDA(At, 0, 1); PG8_STAGE(PG8_SA(0, 0), a2, voffA);
            PG8_BAR; PG8_WAIT_L(0); PG8_MMA(1, 0, At, B0); PG8_BAR; PG8_SCHED;
            PG8_STAGE(PG8_SB(0, 1), b2 + hstep, voffB);
            PG8_WAIT_V(6); PG8_BAR; PG8_MMA(1, 1, At, B1); PG8_BAR;
            PG8_LDB(B0, 1, 0); PG8_SCHED; PG8_LDA(At, 1, 0); PG8_STAGE(PG8_SA(0, 1), a2 + hstep, voffA);
            PG8_WAIT_L(8); PG8_BAR; PG8_WAIT_L(0); PG8_MMA(0, 0, At, B0); PG8_BAR; PG8_SCHED;
            PG8_LDB(B1, 1, 1); PG8_STAGE(PG8_SB(1, 0), b3, voffB);
            PG8_BAR; PG8_WAIT_L(0); PG8_MMA(0, 1, At, B1); PG8_BAR;
            PG8_LDA(At, 1, 1); PG8_STAGE(PG8_SA(1, 0), a3, voffA);
            PG8_BAR; PG8_WAIT_L(0); PG8_MMA(1, 0, At, B0); PG8_BAR; PG8_SCHED;
            PG8_STAGE(PG8_SB(1, 1), b3 + hstep, voffB);
            PG8_WAIT_V(6); PG8_BAR; PG8_MMA(1, 1, At, B1); PG8_BAR;
            }
        }
        if constexpr (ALIGN_EPI) { if (wr == 0) PG8_BAR; }
        if constexpr (!Epi::AFTER_DRAIN) { E(acc, cur, wr, wc, fr, fq); S.done(cur); }
        if (!has_next) break;
#pragma unroll
        for (int a = 0; a < 2; ++a)
#pragma unroll
            for (int b = 0; b < 2; ++b)
#pragma unroll
                for (int m = 0; m < 4; ++m)
#pragma unroll
                    for (int n = 0; n < 2; ++n) acc[a][b][m][n] = (f32x4){0.f, 0.f, 0.f, 0.f};
        cur = nxt; cA = nA; cB = nB; ++ui;
        if constexpr (ALIGN_EPI) { if (wr == 1) PG8_BAR; }
    }
    PG8_WAIT_V(0);
    if constexpr (!ALIGN_EPI) { if (wr == 0) PG8_BAR; }
    PG8_BAR;
    if constexpr (Epi::AFTER_DRAIN) { E.fused(acc, cur, wr, wc, fr, fq, lds, wid, lane); S.done(cur); }
#undef PG8_SA
#undef PG8_SB
#undef PG8_STAGE
#undef PG8_LDA
#undef PG8_LDB
#undef PG8_MMA
#undef PG8_WAIT_V
#undef PG8_WAIT_L
#undef PG8_BAR
#undef PG8_SCHED
}
}
typedef pg8::pg8_lds_t_ pg8_lds_t;
using pg8::bf16_t; using pg8::bf16x8; using pg8::f32x4; using pg8::u32x4; using pg8::cvt_pk_bf16;
typedef float f32x16 __attribute__((ext_vector_type(16)));
#define MFMA32(a, b, c) __builtin_amdgcn_mfma_f32_32x32x16_bf16((a), (b), (c), 0, 0, 0)
typedef unsigned u32x2_t __attribute__((ext_vector_type(2)));
#define DI __device__ __forceinline__
#define LDS_WAIT() asm volatile("s_waitcnt lgkmcnt(0)" ::: "memory")

constexpr int NTHR = 512;
constexpr int T_LAT = 16384, T_ALL = 18432;
constexpr size_t SZ_MOD = (size_t)4 * 9 * 9216 * 4;
constexpr size_t OFF_BAR = 0;
constexpr size_t SZ_BAR = 16384;
constexpr size_t OFF_MOD = OFF_BAR + SZ_BAR;
constexpr size_t OFF_ROPE_RET = OFF_MOD + SZ_MOD;
constexpr size_t OFF_ROPE_AX = OFF_ROPE_RET + (size_t)2048 * 64 * 8;
constexpr size_t OFF_X   = OFF_ROPE_AX + (size_t)64 * 16 * 8;
constexpr size_t OFF_HY  = OFF_X + (size_t)T_ALL * 1024 * 4;
constexpr size_t OFF_WFI = OFF_HY + (size_t)T_ALL * 2048 * 2;
constexpr size_t OFF_WFO = OFF_WFI + (size_t)5632 * 1024 * 2;
constexpr size_t OFF_WMI = OFF_WFO + (size_t)1024 * 2816 * 2;
constexpr size_t OFF_WMO = OFF_WMI + (size_t)6144 * 1024 * 2;
constexpr size_t OFF_WFI2 = OFF_WMO + (size_t)1024 * 2048 * 2;
constexpr size_t OFF_WFO2 = OFF_WFI2 + (size_t)5632 * 1024 * 2;
constexpr size_t OFF_WFOS  = OFF_WFO2 + (size_t)1024 * 2816 * 2;
constexpr size_t OFF_WFOS2 = OFF_WFOS + (size_t)2 * 1024 * 1408 * 2;
constexpr size_t OFF_BIG = OFF_WFOS2 + (size_t)2 * 1024 * 1408 * 2;
constexpr size_t OFF_HID = OFF_BIG;
constexpr size_t OFF_HIDC = OFF_BIG + (size_t)T_ALL * 2816 * 2;
constexpr size_t OFF_PART = OFF_HIDC + (size_t)2 * 2048 * 1408 * 2;
constexpr size_t OFF_ABP = OFF_BIG;
constexpr size_t OFF_QN  = OFF_ABP + (size_t)T_ALL * 3840 * 2;
constexpr size_t OFF_KN  = OFF_QN + (size_t)T_ALL * 512 * 4;
constexpr size_t OFF_VN  = OFF_KN + (size_t)T_ALL * 512 * 4;
constexpr size_t OFF_LA  = OFF_VN + (size_t)T_ALL * 512 * 4;
constexpr size_t OFF_BE  = OFF_LA + (size_t)T_ALL * 8 * 4;
constexpr size_t OFF_ODN = OFF_QN;
constexpr size_t OFF_QD  = OFF_BE + (size_t)T_ALL * 8 * 4;
constexpr size_t OFF_KD  = OFF_QD + (size_t)32 * 2304 * 128 * 2;
constexpr size_t OFF_VT  = OFF_KD + (size_t)32 * 2304 * 128 * 2;
constexpr size_t OFF_DW  = OFF_VT + (size_t)32 * 2304 * 128 * 2;
constexpr size_t OFF_DQE = OFF_DW + (size_t)2 * 1152 * 64 * 128 * 2;
constexpr size_t OFF_DKT = OFF_DQE + (size_t)2 * 1152 * 64 * 128 * 2;
constexpr size_t OFF_DQK = OFF_DKT + (size_t)2 * 1152 * 128 * 64 * 2;
constexpr size_t OFF_DUT = OFF_DQK + (size_t)2 * 1152 * 64 * 64 * 2;
constexpr size_t OFF_DEG = OFF_DUT + (size_t)2 * 1152 * 128 * 64 * 4;
constexpr size_t END_AB  = OFF_DEG + (size_t)2 * 1152 * 4 + 256;
constexpr size_t OFF_RP  = OFF_BIG;
constexpr size_t RP_STRIDE = (size_t)T_ALL * 2048;
constexpr size_t OFF_QR  = OFF_RP + 3 * RP_STRIDE * 2;
constexpr size_t OFF_KR  = OFF_QR + (size_t)T_ALL * 1024 * 2;
constexpr size_t OFF_KDT = OFF_KR + (size_t)T_ALL * 1024 * 2;
constexpr size_t OFF_VTR = OFF_KDT + (size_t)2 * 288 * 8 * 128 * 64 * 2;
constexpr size_t OFF_OR  = OFF_RP;
constexpr size_t END_RET = OFF_VTR + (size_t)288 * 8 * 256 * 64 * 2;
constexpr size_t OFF_WMOS_AB = OFF_HY + (size_t)T_ALL * 1024 * 2;
constexpr size_t OFF_WMOS_RET = END_RET;
constexpr size_t WS_NEED = (END_RET + (size_t)1024 * 2048 * 2) > END_AB ? (END_RET + (size_t)1024 * 2048 * 2) : END_AB;

struct Prm {
    const float *x, *c, *ctx, *c_ctx, *ada_w, *ada_b, *norm_w, *final_norm_w, *ffn_w_in, *ffn_w_out, *ab_w_in, *ab_conv_w, *dn_A_log, *dn_dt_bias,
        *dn_norm_w, *diff_lambda, *diff_subln_w, *ab_w_out, *ret_w_in, *ret_decay_logit, *ret_w_out;
    float* out; unsigned char* ws;
};

typedef const Prm __attribute__((address_space(4)))* PrmC;
DI PrmC get_prm() { auto k = __builtin_amdgcn_kernarg_segment_ptr(); asm volatile("" : "+s"(k)); return (PrmC)k; }
DI float bf2f(unsigned v) { return __uint_as_float(v << 16); }
DI unsigned f2bf(float f) { unsigned u = __float_as_uint(f); return (u + 0x7fffu + ((u >> 16) & 1u)) >> 16; }
DI unsigned pk2(float lo, float hi) { return f2bf(lo) | (f2bf(hi) << 16); }
DI unsigned pk2h(float lo, float hi) { unsigned r; asm("v_cvt_pk_bf16_f32 %0, %1, %2" : "=v"(r) : "v"(lo), "v"(hi)); return r; }
DI void unpack8(const uint4 v, float* f) {
    f[0] = __uint_as_float(v.x << 16); f[1] = __uint_as_float(v.x & 0xffff0000u); f[2] = __uint_as_float(v.y << 16); f[3] = __uint_as_float(v.y & 0xffff0000u);
    f[4] = __uint_as_float(v.z << 16); f[5] = __uint_as_float(v.z & 0xffff0000u); f[6] = __uint_as_float(v.w << 16); f[7] = __uint_as_float(v.w & 0xffff0000u);
}
DI uint4 pack8(const float* f) { uint4 o; o.x = pk2(f[0], f[1]); o.y = pk2(f[2], f[3]); o.z = pk2(f[4], f[5]); o.w = pk2(f[6], f[7]); return o; }
template <int CTRL> DI float dpp_f(float v) { return __int_as_float(__builtin_amdgcn_update_dpp(0, __float_as_int(v), CTRL, 0xF, 0xF, true)); }
DI float sum4(float v)  { v += dpp_f<0xB1>(v); v += dpp_f<0x4E>(v); return v; }
DI float sum8(float v)  { v = sum4(v); v += dpp_f<0x141>(v); return v; }
DI float sum16(float v) { v = sum8(v); v += dpp_f<0x140>(v); return v; }
DI float wave_sum(float v) {
#pragma unroll
    for (int o = 1; o < 64; o <<= 1) v += __shfl_xor(v, o);
    return v;
}
DI float silu_f(float g) { return g / (1.0f + __expf(-g)); }

DI void phase_mod(PrmC p, unsigned char* smem) {
    float* s_sh = (float*)smem;
    unsigned redb_ = 9 * 1024 * 4; asm volatile("" : "+v"(redb_));
    __attribute__((address_space(3))) float* red = (__attribute__((address_space(3))) float*)(uintptr_t)redb_;
    float* MOD = (float*)(p->ws + OFF_MOD);
    const int tid = opaque_tid(), lane = tid & 63, ks = tid >> 6;
    { float2* RT = (float2*)(p->ws + OFF_ROPE_RET); float2* AX = (float2*)(p->ws + OFF_ROPE_AX);
      for (int i = bid() * NTHR + tid; i < 2048 * 64; i += gdim() * NTHR) { const float ang = (float)(i >> 6) * exp2f(-(float)(i & 63) * (13.287712379549449f / 63.0f)); RT[i] = make_float2(cosf(ang), sinf(ang)); }
      for (int i = bid() * NTHR + tid; i < 64 * 16; i += gdim() * NTHR) { const float ang = (float)(i >> 4) * exp2f(-(float)(i & 15) * (13.287712379549449f / 16.0f)); AX[i] = make_float2(cosf(ang), sinf(ang)); } }
    for (int i = tid; i < 9 * 1024; i += NTHR) { const int rr = i >> 10, kk = i & 1023; const float cv = rr < 8 ? p->c[rr * 1024 + kk] : p->c_ctx[kk]; s_sh[i] = silu_f(cv); }
    __syncthreads();
    for (int it = bid(); it < 144; it += gdim()) {
        const int l = it / 36, cb = it % 36, col = cb * 256 + lane * 4;
        const float* w = p->ada_w + ((size_t)l * 1024 + ks * 128) * 9216 + col;
        float acc[9][4];
#pragma unroll
        for (int a = 0; a < 9; ++a) { acc[a][0] = 0.f; acc[a][1] = 0.f; acc[a][2] = 0.f; acc[a][3] = 0.f; }
#pragma unroll 4
        for (int k = 0; k < 128; ++k) { const float4 wv = *(const float4*)(w + (size_t)k * 9216);
#pragma unroll
            for (int a = 0; a < 9; ++a) { const float sv = s_sh[a * 1024 + ks * 128 + k]; acc[a][0] += sv * wv.x; acc[a][1] += sv * wv.y; acc[a][2] += sv * wv.z; acc[a][3] += sv * wv.w; } }
#pragma unroll
        for (int a = 0; a < 9; ++a) *(float4*)(red + (ks * 9 + a) * 256 + lane * 4) = make_float4(acc[a][0], acc[a][1], acc[a][2], acc[a][3]);
        __syncthreads();
        for (int o = tid; o < 9 * 256; o += NTHR) { const int a = o >> 8, c = o & 255; float v = p->ada_b[l * 9216 + cb * 256 + c];
#pragma unroll
            for (int q = 0; q < 8; ++q) v += red[(q * 9 + a) * 256 + c];
            MOD[((size_t)l * 9 + a) * 9216 + cb * 256 + c] = v; }
        __syncthreads();
    }
}

template <int MODE> DI int dest_row(int n) {
    if (MODE == 0 || MODE == 3) return n;
    if (MODE == 1) { const int bj = n >= 2816 ? 1 : 0, r = n - bj * 2816; return 256 * (r >> 7) + 128 * bj + (r & 127); }
    return n < 2048 ? n : (n < 2064 ? 3584 + (n - 2048) : n - 16);
}
template <int MODE> DI void convert_weights(const float* W, int K, int N, bf16_t* WT, float* scr, int gw, int NGW, int& rot, int khalf = 1408, bf16_t* WT2 = nullptr) {
    const int lane = opaque_tid() & 63;
    const int nblk = (N + 63) >> 6, nitems = (K >> 6) * nblk;
    int first = gw - rot; if (first < 0) first += NGW;
    for (int item = first; item < nitems; item += NGW) {
        const int kb = item / nblk, nb = item - kb * nblk, k0 = kb << 6, n0 = nb << 6;
        const int nl = (lane & 15) * 4, kr = lane >> 4;
        const bool ok = n0 + nl < N;
        float4 v[16];
#pragma unroll
        for (int i = 0; i < 16; ++i) v[i] = ok ? *(const float4*)(W + (size_t)(k0 + 4 * i + kr) * N + n0 + nl) : make_float4(0.f, 0.f, 0.f, 0.f);
#pragma unroll
        for (int i = 0; i < 16; ++i) *(float4*)(scr + (4 * i + kr) * 68 + nl) = v[i];
        LDS_WAIT();
        const int nn = n0 + lane;
        if (nn < N) {
            bf16_t* dst = MODE == 3 ? WT + ((size_t)(k0 / khalf) * 1024 + nn) * khalf + (k0 % khalf) : WT + (size_t)dest_row<MODE>(nn) * K + k0;
            bf16_t* dst2 = WT2 ? WT2 + ((size_t)(k0 / khalf) * 1024 + nn) * khalf + (k0 % khalf) : nullptr;
#pragma unroll
            for (int kg = 0; kg < 8; ++kg) { const float* t = scr + (8 * kg) * 68 + lane;
                uint4 o; o.x = pk2(t[0 * 68], t[1 * 68]); o.y = pk2(t[2 * 68], t[3 * 68]); o.z = pk2(t[4 * 68], t[5 * 68]); o.w = pk2(t[6 * 68], t[7 * 68]);
                *(uint4*)(dst + 8 * kg) = o; if (WT2) *(uint4*)(dst2 + 8 * kg) = o; }
        }
        LDS_WAIT();
    }
    rot = (rot + nitems) % NGW;
}

DI void norm_rows(PrmC p, const float* xlat, const float* xctx, int l, int sub, int nrows, int gw, int NGW, int& rot, const float* fixgate, float fixs) {
    const int lane = opaque_tid() & 63;
    const float* MOD = (const float*)(p->ws + OFF_MOD);
    bf16_t* H = (bf16_t*)(p->ws + OFF_HY);
    const float* nw = p->norm_w + ((size_t)l * 3 + sub) * 1024;
    int first = gw - rot; if (first < 0) first += NGW;
    for (int row0 = first; row0 < nrows; row0 += 2 * NGW) {
        const int row1 = row0 + NGW; const bool has1 = row1 < nrows; const int r1 = has1 ? row1 : row0;
        const float* xa = row0 < T_LAT ? xlat + (size_t)row0 * 1024 : xctx + (size_t)(row0 - T_LAT) * 1024;
        const float* xb = r1 < T_LAT ? xlat + (size_t)r1 * 1024 : xctx + (size_t)(r1 - T_LAT) * 1024;
        float4 va[4], vb[4]; float sa = 0.f, sb = 0.f;
#pragma unroll
        for (int j = 0; j < 4; ++j) { va[j] = *(const float4*)(xa + j * 256 + lane * 4); vb[j] = *(const float4*)(xb + j * 256 + lane * 4); }
        if (fixgate) {
            const float* PART = (const float*)(p->ws + OFF_PART); float* X = (float*)(p->ws + OFF_X);
            if (row0 >= T_LAT) { const float* p0 = PART + (size_t)(row0 - T_LAT) * 1024; const float* p1 = p0 + (size_t)2048 * 1024;
#pragma unroll
                for (int j = 0; j < 4; ++j) { const int c = j * 256 + lane * 4; const float4 g = *(const float4*)(fixgate + c), a = *(const float4*)(p0 + c), b2 = *(const float4*)(p1 + c);
                    va[j].x += fixs * g.x * (a.x + b2.x); va[j].y += fixs * g.y * (a.y + b2.y); va[j].z += fixs * g.z * (a.z + b2.z); va[j].w += fixs * g.w * (a.w + b2.w);
                    *(float4*)(X + (size_t)row0 * 1024 + c) = va[j]; } }
            if (has1 && row1 >= T_LAT) { const float* p0 = PART + (size_t)(row1 - T_LAT) * 1024; const float* p1 = p0 + (size_t)2048 * 1024;
#pragma unroll
                for (int j = 0; j < 4; ++j) { const int c = j * 256 + lane * 4; const float4 g = *(const float4*)(fixgate + c), a = *(const float4*)(p0 + c), b2 = *(const float4*)(p1 + c);
                    vb[j].x += fixs * g.x * (a.x + b2.x); vb[j].y += fixs * g.y * (a.y + b2.y); vb[j].z += fixs * g.z * (a.z + b2.z); vb[j].w += fixs * g.w * (a.w + b2.w);
                    *(float4*)(X + (size_t)row1 * 1024 + c) = vb[j]; } }
        }
#pragma unroll
        for (int j = 0; j < 4; ++j) { sa += va[j].x * va[j].x + va[j].y * va[j].y + va[j].z * va[j].z + va[j].w * va[j].w; sb += vb[j].x * vb[j].x + vb[j].y * vb[j].y + vb[j].z * vb[j].z + vb[j].w * vb[j].w; }
#pragma unroll
        for (int o = 1; o < 64; o <<= 1) { sa += __shfl_xor(sa, o); sb += __shfl_xor(sb, o); }
        const float ra = rsqrtf(sa * (1.0f / 1024.0f) + 1e-6f), rb = rsqrtf(sb * (1.0f / 1024.0f) + 1e-6f);
        const float* mda = MOD + (((size_t)l * 9 + (row0 < T_LAT ? (row0 >> 11) : 8)) * 9 + 3 * sub) * 1024;
        const float* mdb = MOD + (((size_t)l * 9 + (r1 < T_LAT ? (r1 >> 11) : 8)) * 9 + 3 * sub) * 1024;
#pragma unroll
        for (int j = 0; j < 4; ++j) { const int c = j * 256 + lane * 4;
            const float4 w = *(const float4*)(nw + c);
            { const float4 sh = *(const float4*)(mda + c), sc = *(const float4*)(mda + 1024 + c);
              uint2 o; o.x = pk2h(va[j].x * ra * w.x * (1.f + sc.x) + sh.x, va[j].y * ra * w.y * (1.f + sc.y) + sh.y); o.y = pk2h(va[j].z * ra * w.z * (1.f + sc.z) + sh.z, va[j].w * ra * w.w * (1.f + sc.w) + sh.w);
              *(uint2*)(H + (size_t)row0 * 1024 + c) = o; }
            if (has1) { const float4 sh = *(const float4*)(mdb + c), sc = *(const float4*)(mdb + 1024 + c);
              uint2 o; o.x = pk2h(vb[j].x * rb * w.x * (1.f + sc.x) + sh.x, vb[j].y * rb * w.y * (1.f + sc.y) + sh.y); o.y = pk2h(vb[j].z * rb * w.z * (1.f + sc.z) + sh.z, vb[j].w * rb * w.w * (1.f + sc.w) + sh.w);
              *(uint2*)(H + (size_t)row1 * 1024 + c) = o; } }
    }
    rot = (rot + nrows) % NGW;
}

DI void phase_ab_prep(PrmC p, int ai, unsigned char* smem) {
    const bf16_t* P = (const bf16_t*)(p->ws + OFF_ABP);
    bf16_t* QN = (bf16_t*)(p->ws + OFF_QN); bf16_t* KN = (bf16_t*)(p->ws + OFF_KN); float* VN = (float*)(p->ws + OFF_VN);
    float* LA = (float*)(p->ws + OFF_LA); float* BE = (float*)(p->ws + OFF_BE);
    bf16_t* QD = (bf16_t*)(p->ws + OFF_QD); bf16_t* KD = (bf16_t*)(p->ws + OFF_KD); bf16_t* VT = (bf16_t*)(p->ws + OFF_VT);
    const float* cw = p->ab_conv_w + (size_t)ai * 3 * 1536;
    bf16_t* vt_l = (bf16_t*)smem;
    const int tid = opaque_tid(), lane = tid & 63, wave = tid >> 6;
    for (int item = bid(); item < T_ALL / 16; item += gdim()) {
        const int r0 = item * 16; const bool lat = r0 < T_LAT;
        const int b = lat ? (r0 >> 11) : ((r0 - T_LAT) >> 8), t0 = lat ? (r0 & 2047) : ((r0 - T_LAT) & 255), Ls = lat ? 2048 : 256, key0 = lat ? 256 + t0 : t0;
        __syncthreads();
        for (int idx = tid; idx < 1024; idx += NTHR) { const int rr = idx >> 6, seg = idx & 63;
            *(uint4*)(vt_l + rr * 520 + seg * 8) = *(const uint4*)(P + (size_t)(r0 + rr) * 3840 + 3072 + seg * 8); }
        __syncthreads();
        { const int hh = tid >> 7, dv = tid & 127; unsigned w[8];
#pragma unroll
            for (int k = 0; k < 8; ++k) w[k] = (unsigned)vt_l[(2 * k) * 520 + tid] | ((unsigned)vt_l[(2 * k + 1) * 520 + tid] << 16);
            bf16_t* dst = VT + ((size_t)((b * 4 + hh) * 128 + dv)) * 2304 + key0;
            *(uint4*)dst = make_uint4(w[0], w[1], w[2], w[3]); *(uint4*)(dst + 8) = make_uint4(w[4], w[5], w[6], w[7]); }
#pragma unroll
        for (int tt = 0; tt < 2; ++tt) {
            const int row = r0 + 2 * wave + tt, ti = t0 + 2 * wave + tt;
            const bf16_t* pr = P + (size_t)row * 3840;
            float res[3][8];
#pragma unroll
            for (int sec = 0; sec < 3; ++sec) {
                const int ch = sec * 512 + lane * 8;
                float acc[8];
#pragma unroll
                for (int e = 0; e < 8; ++e) acc[e] = 0.f;
#pragma unroll
                for (int tap = 0; tap < 3; ++tap) {
                    const int tn = ti + tap - 1;
                    if (tn >= 0 && tn < Ls) {
                        float u[8]; unpack8(*(const uint4*)(pr + (ptrdiff_t)(tap - 1) * 3840 + ch), u);
                        const float4 w0 = *(const float4*)(cw + tap * 1536 + ch), w1 = *(const float4*)(cw + tap * 1536 + ch + 4);
                        acc[0] += w0.x * u[0]; acc[1] += w0.y * u[1]; acc[2] += w0.z * u[2]; acc[3] += w0.w * u[3];
                        acc[4] += w1.x * u[4]; acc[5] += w1.y * u[5]; acc[6] += w1.z * u[6]; acc[7] += w1.w * u[7];
                    }
                }
#pragma unroll
                for (int e = 0; e < 8; ++e) res[sec][e] = silu_f(acc[e]);
            }
            { float sq = 0.f, sk = 0.f;
#pragma unroll
              for (int e = 0; e < 8; ++e) { sq += res[0][e] * res[0][e]; sk += res[1][e] * res[1][e]; }
              sq = sum16(sq); sk = sum16(sk);
              const float rq = rsqrtf(sq + 1e-6f) * 0.08838834764831845f, rk = rsqrtf(sk + 1e-6f);
              float* vo = VN + (size_t)row * 512 + lane * 8;
              float qs8[8], ks8[8];
#pragma unroll
              for (int e = 0; e < 8; ++e) { qs8[e] = res[0][e] * rq; ks8[e] = res[1][e] * rk; }
              *(uint4*)(QN + (size_t)row * 512 + lane * 8) = pack8(qs8); *(uint4*)(KN + (size_t)row * 512 + lane * 8) = pack8(ks8);
              *(float4*)vo = make_float4(res[2][0], res[2][1], res[2][2], res[2][3]); *(float4*)(vo + 4) = make_float4(res[2][4], res[2][5], res[2][6], res[2][7]); }
            if (lane < 8) { const float a = bf2f(pr[3584 + lane]) + p->dn_dt_bias[ai * 8 + lane];
                const float sp = a > 20.f ? a : log1pf(__expf(a));
                LA[(size_t)row * 8 + lane] = -__expf(p->dn_A_log[ai * 8 + lane]) * sp; }
            else if (lane < 16) { const float bb = bf2f(pr[3592 + lane - 8]); BE[(size_t)row * 8 + lane - 8] = 1.0f / (1.0f + __expf(-bb)); }
            { float q[8], k[8]; unpack8(*(const uint4*)(pr + 2048 + lane * 8), q); unpack8(*(const uint4*)(pr + 2560 + lane * 8), k);
              const int hh = lane >> 4, cc = (lane & 15) * 8, d0 = cc & 63;
              if (lat) {
                  const int o = d0 & 31; const int ipos = (d0 & 32) ? (ti & 63) : (ti >> 6); const bool firsth = o < 16;
                  const float2* ax = (const float2*)(p->ws + OFF_ROPE_AX) + ipos * 16 + (o & 15);
#pragma unroll
                  for (int e = 0; e < 8; ++e) {
                      const float qp = __shfl_xor(q[e], 2), kp = __shfl_xor(k[e], 2);
                      const float2 cs2 = ax[e];
                      q[e] = q[e] * cs2.x + (firsth ? -qp : qp) * cs2.y; k[e] = k[e] * cs2.x + (firsth ? -kp : kp) * cs2.y;
                  }
              }
              const float qs = 0.125f * 1.4426950408889634f;
#pragma unroll
              for (int e = 0; e < 8; ++e) q[e] *= qs;
              const size_t off = ((size_t)(b * 4 + hh) * 2304 + key0 + 2 * wave + tt) * 128 + cc;
              *(uint4*)(QD + off) = pack8(q); *(uint4*)(KD + off) = pack8(k); }
        }
    }
}

DI int xcd_group_item(int blk, int G) { if (G != 256) return blk; const int x = blk & 7, k = blk >> 3; return ((x + 8 * (k >> 2)) << 2) + (k & 3); }
DI int seq_row(int b, int dir, int pos) {
    if (pos < 256) return T_LAT + b * 256 + (dir ? 255 - pos : pos);
    const int i = pos - 256; return b * 2048 + (dir ? 2047 - i : i);
}
typedef float __attribute__((address_space(3)))* lf_t;
typedef float __attribute__((address_space(3)))* lf_t;
template <int D> DI void dn_rhs(float (&x)[64], const float* VN, lf_t Kl, lf_t Gn, lf_t Bn, int row0, int h, int t) {
            asm volatile("" : "+v"(t));
            const lf_t Gd = Gn + D * 64, Bd = Bn + D * 64;
            if (t < 128) {
                unsigned voff = (unsigned)(((row0 + (D ? 63 : 0)) * 512 + h * 128 + t) * 4);
#pragma unroll
                for (int pi = 0; pi < 64; ++pi) { const int n = D ? 63 - pi : pi; x[pi] = *(const float*)((const char*)VN + voff) * Bd[n]; voff += D ? -2048 : 2048; asm volatile("" : "+v"(voff)); }
            } else {
#pragma unroll
                for (int pi = 0; pi < 64; ++pi) { const int n = D ? 63 - pi : pi; x[pi] = Kl[n * 132 + (t - 128)] * Bd[n] * __expf(Gd[n]); }
            }
}
DI void dn_solve_core(float (&x)[64], lf_t Ad) {
    float4 cur[16], nxt[16];
    cur[0] = *(const float4*)(Ad + 68);
#pragma unroll
    for (int pi = 1; pi < 64; ++pi) {
        if (pi + 1 < 64) {
#pragma unroll
            for (int g4 = 0; g4 < (pi + 4) / 4; ++g4) nxt[g4] = *(const float4*)(Ad + (pi + 1) * 68 + 4 * g4);
        }
        float a = x[pi], a2 = 0.f;
#pragma unroll
        for (int g4 = 0; g4 < (pi + 3) / 4; ++g4) { const float4 av = cur[g4];
            if (4 * g4 + 0 < pi) a -= av.x * x[4 * g4 + 0];
            if (4 * g4 + 1 < pi) a2 -= av.y * x[4 * g4 + 1];
            if (4 * g4 + 2 < pi) a -= av.z * x[4 * g4 + 2];
            if (4 * g4 + 3 < pi) a2 -= av.w * x[4 * g4 + 3]; }
        x[pi] = a + a2;
        asm volatile("" ::: "memory");
#pragma unroll
        for (int g4 = 0; g4 < (pi + 4) / 4; ++g4) cur[g4] = nxt[g4];
    }
}
template <int D> DI void dn_out(float (&x)[64], lf_t Kl, lf_t Ql, lf_t Gn, bf16_t* DW, bf16_t* DQE, bf16_t* DKT, bf16_t* DUT, float* DEG, int item, int t) {
            asm volatile("" : "+v"(t));
            const lf_t Gd = Gn + D * 64;
            if (t < 128) { bf16_t* uo = DUT + (((size_t)D * 1152 + item) * 128 + t) * 64;
#pragma unroll
                for (int g8 = 0; g8 < 8; ++g8) *(uint4*)(uo + 8 * g8) = pack8(x + 8 * g8);
            } else { bf16_t* wbase = DW + (((size_t)D * 1152 + item) * 64) * 128; unsigned woff = (unsigned)((t - 128) * 2);
#pragma unroll
                for (int pi = 0; pi < 64; ++pi) { *(bf16_t*)((char*)wbase + woff) = (bf16_t)f2bf(x[pi]); woff += 256; asm volatile("" : "+v"(woff)); } }
            const float glast = Gd[D ? 0 : 63];
#pragma unroll
            for (int i = 0; i < 4; ++i) { const int idx = t + 256 * i, pi = idx >> 4, seg = idx & 15, n = D ? 63 - pi : pi; const float e = __expf(Gd[n]);
                const float4 a0 = *(const float4*)(Ql + n * 132 + seg * 8), a1 = *(const float4*)(Ql + n * 132 + seg * 8 + 4);
                uint4 o; o.x = pk2(a0.x * e, a0.y * e); o.y = pk2(a0.z * e, a0.w * e); o.z = pk2(a1.x * e, a1.y * e); o.w = pk2(a1.z * e, a1.w * e);
                *(uint4*)(DQE + (((size_t)D * 1152 + item) * 64 + pi) * 128 + seg * 8) = o; }
#pragma unroll
            for (int i = 0; i < 4; ++i) { const int idx = t + 256 * i, dk = idx & 127, pg = idx >> 7; float v[8];
#pragma unroll
                for (int e = 0; e < 8; ++e) { const int pi = 8 * pg + e, n = D ? 63 - pi : pi; v[e] = Kl[n * 132 + dk] * __expf(glast - Gd[n]); }
                *(uint4*)(DKT + (((size_t)D * 1152 + item) * 128 + dk) * 64 + 8 * pg) = pack8(v); }
            if (t == 0) DEG[D * 1152 + item] = __expf(glast);
}

DI void phase_dn_chunkprep(PrmC p, unsigned char* smem, int vb, int nvb) {
    const bf16_t* QN = (const bf16_t*)(p->ws + OFF_QN); const bf16_t* KN = (const bf16_t*)(p->ws + OFF_KN); const float* VN = (const float*)(p->ws + OFF_VN);
    const float* LA = (const float*)(p->ws + OFF_LA); const float* BE = (const float*)(p->ws + OFF_BE);
    bf16_t* DW = (bf16_t*)(p->ws + OFF_DW); bf16_t* DQE = (bf16_t*)(p->ws + OFF_DQE); bf16_t* DKT = (bf16_t*)(p->ws + OFF_DKT); bf16_t* DQK = (bf16_t*)(p->ws + OFF_DQK);
    bf16_t* DUT = (bf16_t*)(p->ws + OFF_DUT); float* DEG = (float*)(p->ws + OFF_DEG);
    typedef float __attribute__((address_space(3)))* lf;
    unsigned bK_ = 0u, bQ_ = 64 * 132 * 4, bA_ = 2 * 64 * 132 * 4, bG_ = 2 * 64 * 132 * 4 + 2 * 64 * 68 * 4, bB_ = 2 * 64 * 132 * 4 + 2 * 64 * 68 * 4 + 1024;
    asm volatile("" : "+v"(bK_), "+v"(bQ_), "+v"(bA_), "+v"(bG_), "+v"(bB_));
    typedef __attribute__((address_space(3))) unsigned char* lb;
    const lb Kb = (lb)(uintptr_t)bB_, Qb = Kb + 64 * 272;
    const lf Kl = (lf)(uintptr_t)bK_, Ql = (lf)(uintptr_t)bQ_, Al = (lf)(uintptr_t)bA_, Gn = (lf)(uintptr_t)bG_, Bn = Gn + 128;
    (void)smem;
    const int tid = opaque_tid(), d = __builtin_amdgcn_readfirstlane(tid >> 8), t = tid & 255;
    for (int item = vb < 0 ? 1152 : vb; item < 1152; item += nvb) {
        const int cidx = item % 36, bh = item / 36, h = bh & 3, b = bh >> 2;
        const int row0 = cidx < 4 ? T_LAT + b * 256 + cidx * 64 : b * 2048 + (cidx - 4) * 64;
        __syncthreads();
#pragma unroll
        for (int i = 0; i < 2; ++i) { const int idx = tid + i * NTHR, n = idx >> 4, seg = idx & 15; float kf[8], qf8[8];
            const uint4 kraw = *(const uint4*)(KN + (size_t)(row0 + n) * 512 + h * 128 + seg * 8), qraw = *(const uint4*)(QN + (size_t)(row0 + n) * 512 + h * 128 + seg * 8);
            unpack8(kraw, kf); unpack8(qraw, qf8);
            *(__attribute__((address_space(3))) u32x4*)(Kb + n * 272 + seg * 16) = (u32x4){kraw.x, kraw.y, kraw.z, kraw.w}; *(__attribute__((address_space(3))) u32x4*)(Qb + n * 272 + seg * 16) = (u32x4){qraw.x, qraw.y, qraw.z, qraw.w};
            *(float4*)(Kl + n * 132 + seg * 8) = make_float4(kf[0], kf[1], kf[2], kf[3]); *(float4*)(Kl + n * 132 + seg * 8 + 4) = make_float4(kf[4], kf[5], kf[6], kf[7]);
            *(float4*)(Ql + n * 132 + seg * 8) = make_float4(qf8[0], qf8[1], qf8[2], qf8[3]); *(float4*)(Ql + n * 132 + seg * 8 + 4) = make_float4(qf8[4], qf8[5], qf8[6], qf8[7]); }
        if (t < 64) {
            const int n = d ? 63 - t : t;
            float x = LA[(size_t)(row0 + n) * 8 + d * 4 + h];
#pragma unroll
            for (int o = 1; o < 64; o <<= 1) { const float y = __shfl_up(x, o); if (t >= o) x += y; }
            Gn[d * 64 + n] = x; Bn[d * 64 + n] = BE[(size_t)(row0 + n) * 8 + d * 4 + h];
        }
        __syncthreads();
        {
            int tb = tid; asm volatile("" : "+v"(tb));
            const int lane = tb & 63, wv = tb >> 6, r = lane & 31, hh = lane >> 5, sel = wv >> 2, it = (wv >> 1) & 1, jt = wv & 1;
            const lb Ab = sel ? Qb : Kb;
            f32x16 acc;
#pragma unroll
            for (int i = 0; i < 16; ++i) acc[i] = 0.f;
#pragma unroll
            for (int ks = 0; ks < 8; ++ks) { const bf16x8 a = *(const __attribute__((address_space(3))) bf16x8*)(Ab + (32 * it + r) * 272 + (16 * ks + 8 * hh) * 2);
                const bf16x8 bb = *(const __attribute__((address_space(3))) bf16x8*)(Kb + (32 * jt + r) * 272 + (16 * ks + 8 * hh) * 2); acc = MFMA32(a, bb, acc); }
            const int nj = 32 * jt + r; const float g0j = Gn[nj], g1j = Gn[64 + nj];
            if (sel == 0) {
#pragma unroll
                for (int i = 0; i < 16; ++i) { const int ni = 32 * it + (i & 3) + 8 * (i >> 2) + 4 * hh;
                    if (ni > nj) Al[ni * 68 + nj] = Bn[ni] * acc[i] * __expf(Gn[ni] - g0j);
                    else if (ni < nj) Al[64 * 68 + (63 - ni) * 68 + (63 - nj)] = Bn[64 + ni] * acc[i] * __expf(Gn[64 + ni] - g1j); }
            } else {
                bf16_t* q0 = DQK + ((size_t)item * 64) * 64; bf16_t* q1 = DQK + ((size_t)(1152 + item) * 64) * 64;
#pragma unroll
                for (int i = 0; i < 16; ++i) { const int ni = 32 * it + (i & 3) + 8 * (i >> 2) + 4 * hh;
                    const float v0 = ni >= nj ? acc[i] * __expf(Gn[ni] - g0j) : 0.f, v1 = ni <= nj ? acc[i] * __expf(Gn[64 + ni] - g1j) : 0.f;
                    q0[ni * 64 + nj] = (bf16_t)f2bf(v0); q1[(63 - ni) * 64 + (63 - nj)] = (bf16_t)f2bf(v1); }
            }
        }
        __syncthreads();
        { float x[64];
          if (d == 0) dn_rhs<0>(x, VN, Kl, Gn, Bn, row0, h, t); else dn_rhs<1>(x, VN, Kl, Gn, Bn, row0, h, t);
          dn_solve_core(x, Al + d * 64 * 68);
          if (d == 0) dn_out<0>(x, Kl, Ql, Gn, DW, DQE, DKT, DUT, DEG, item, t); else dn_out<1>(x, Kl, Ql, Gn, DW, DQE, DKT, DUT, DEG, item, t); }
    }
}

#define MFMA16(a, b, c) __builtin_amdgcn_mfma_f32_16x16x32_bf16((a), (b), (c), 0, 0, 0)
constexpr int DS_PITCH = 272, DV_PITCH = 144, D_ST = 0, D_VN = 2 * 32 * DS_PITCH, D_EG = D_VN + 32 * DV_PITCH, D_OB = D_EG + 256;
DI void phase_dn_chunkrec(PrmC p, unsigned char* smem) {
    const bf16_t* DW = (const bf16_t*)(p->ws + OFF_DW); const bf16_t* DQE = (const bf16_t*)(p->ws + OFF_DQE); const bf16_t* DKT = (const bf16_t*)(p->ws + OFF_DKT); const bf16_t* DQK = (const bf16_t*)(p->ws + OFF_DQK);
    const bf16_t* DUT = (const bf16_t*)(p->ws + OFF_DUT); const float* DEG = (const float*)(p->ws + OFF_DEG);
    bf16_t* ODN = (bf16_t*)(p->ws + OFF_ODN);
    const int tid = opaque_tid(), lane = tid & 63, wave = tid >> 6, r16 = lane & 15, q4 = lane >> 4, rt = wave >> 1, ct = wave & 1;
    for (int item0 = bid(); item0 < 256; item0 += gdim()) {
        const int item = xcd_group_item(item0, gdim());
        const int sl = item & 3, dir = (item >> 2) & 1, h = (item >> 3) & 3, b = item >> 5, bh = b * 4 + h;
        f32x4 Sacc[2];
        Sacc[0] = (f32x4){0.f, 0.f, 0.f, 0.f}; Sacc[1] = Sacc[0];
        __syncthreads();
        for (int i = tid; i < 32 * DS_PITCH / 16; i += NTHR) *(uint4*)(smem + D_ST + i * 16) = make_uint4(0, 0, 0, 0);
        uint4 wf0, wf1, wf2, wf3, qf0, qf1, qf2, qf3, qk0, qk1, kd00, kd01, kd10, kd11; uint2 uf;
        uint4 nwf0, nwf1, nwf2, nwf3, nqf0, nqf1, nqf2, nqf3, nqk0, nqk1, nkd00, nkd01, nkd10, nkd11; uint2 nuf;
#define DC_CIDX(ch) ((ch) < 4 ? (dir ? 3 - (ch) : (ch)) : 4 + (dir ? 35 - (ch) : (ch) - 4))
#define DC_LOAD(ch, P_) do { const size_t ci_ = (size_t)dir * 1152 + bh * 36 + DC_CIDX(ch); \
            const bf16_t* w_ = DW + (ci_ * 64 + 16 * rt + r16) * 128 + 8 * q4; const bf16_t* e_ = DQE + (ci_ * 64 + 16 * rt + r16) * 128 + 8 * q4; \
            P_##wf0 = *(const uint4*)(w_); P_##wf1 = *(const uint4*)(w_ + 32); P_##wf2 = *(const uint4*)(w_ + 64); P_##wf3 = *(const uint4*)(w_ + 96); \
            P_##qf0 = *(const uint4*)(e_); P_##qf1 = *(const uint4*)(e_ + 32); P_##qf2 = *(const uint4*)(e_ + 64); P_##qf3 = *(const uint4*)(e_ + 96); \
            const bf16_t* k_ = DQK + (ci_ * 64 + 16 * rt + r16) * 64 + 8 * q4; P_##qk0 = *(const uint4*)(k_); P_##qk1 = *(const uint4*)(k_ + 32); \
            const bf16_t* t_ = DKT + (ci_ * 128 + 32 * rt + r16) * 64 + 8 * q4; P_##kd00 = *(const uint4*)(t_); P_##kd01 = *(const uint4*)(t_ + 32); P_##kd10 = *(const uint4*)(t_ + 16 * 64); P_##kd11 = *(const uint4*)(t_ + 16 * 64 + 32); \
            P_##uf = *(const uint2*)(DUT + (ci_ * 128 + sl * 32 + 16 * ct + r16) * 64 + 16 * rt + 4 * q4); } while (0)
        if (tid < 36) ((float*)(smem + D_EG))[tid] = DEG[(size_t)dir * 1152 + bh * 36 + DC_CIDX(tid)];
        DC_LOAD(0, );
        __syncthreads();
#pragma unroll 1
        for (int ch = 0; ch < 36; ++ch) {
            if (ch + 1 < 36) DC_LOAD(ch + 1, n);
            const unsigned char* stc = smem + D_ST + (ch & 1) * 32 * DS_PITCH; unsigned char* stn = smem + D_ST + ((ch + 1) & 1) * 32 * DS_PITCH;
            f32x4 accW = (f32x4){0.f, 0.f, 0.f, 0.f}, accQ = accW;
            { const unsigned char* sb = stc + (16 * ct + r16) * DS_PITCH + 8 * q4 * 2;
              const bf16x8 s0 = *(const bf16x8*)(sb), s1 = *(const bf16x8*)(sb + 64), s2 = *(const bf16x8*)(sb + 128), s3 = *(const bf16x8*)(sb + 192);
              accW = MFMA16(__builtin_bit_cast(bf16x8, wf0), s0, accW); accW = MFMA16(__builtin_bit_cast(bf16x8, wf1), s1, accW); accW = MFMA16(__builtin_bit_cast(bf16x8, wf2), s2, accW); accW = MFMA16(__builtin_bit_cast(bf16x8, wf3), s3, accW);
              accQ = MFMA16(__builtin_bit_cast(bf16x8, qf0), s0, accQ); accQ = MFMA16(__builtin_bit_cast(bf16x8, qf1), s1, accQ); accQ = MFMA16(__builtin_bit_cast(bf16x8, qf2), s2, accQ); accQ = MFMA16(__builtin_bit_cast(bf16x8, qf3), s3, accQ); }
            { const float v0 = bf2f(uf.x & 0xffffu) - accW[0], v1 = __uint_as_float(uf.x & 0xffff0000u) - accW[1], v2 = bf2f(uf.y & 0xffffu) - accW[2], v3 = __uint_as_float(uf.y & 0xffff0000u) - accW[3];
              uint2 o; o.x = pk2h(v0, v1); o.y = pk2h(v2, v3);
              *(uint2*)(smem + D_VN + (16 * ct + r16) * DV_PITCH + (16 * rt + 4 * q4) * 2) = o; }
            __syncthreads();
            { const unsigned char* vb = smem + D_VN + (16 * ct + r16) * DV_PITCH + 8 * q4 * 2;
              const bf16x8 v0 = *(const bf16x8*)(vb), v1 = *(const bf16x8*)(vb + 64);
              accQ = MFMA16(__builtin_bit_cast(bf16x8, qk0), v0, accQ); accQ = MFMA16(__builtin_bit_cast(bf16x8, qk1), v1, accQ);
              const float egl = ((const float*)(smem + D_EG))[ch];
              Sacc[0] = Sacc[0] * egl; Sacc[1] = Sacc[1] * egl;
              Sacc[0] = MFMA16(__builtin_bit_cast(bf16x8, kd00), v0, Sacc[0]); Sacc[0] = MFMA16(__builtin_bit_cast(bf16x8, kd01), v1, Sacc[0]);
              Sacc[1] = MFMA16(__builtin_bit_cast(bf16x8, kd10), v0, Sacc[1]); Sacc[1] = MFMA16(__builtin_bit_cast(bf16x8, kd11), v1, Sacc[1]); }
            wf0 = nwf0; wf1 = nwf1; wf2 = nwf2; wf3 = nwf3; qf0 = nqf0; qf1 = nqf1; qf2 = nqf2; qf3 = nqf3; qk0 = nqk0; qk1 = nqk1; kd00 = nkd00; kd01 = nkd01; kd10 = nkd10; kd11 = nkd11; uf = nuf;
            asm volatile("" ::: "memory");
            { float* ob = (float*)(smem + D_OB) + ((ch % 12) * 64 + 16 * rt + 4 * q4) * 32 + 16 * ct + r16;
#pragma unroll
              for (int j = 0; j < 4; ++j) ob[j * 32] = accQ[j]; }
#pragma unroll
            for (int tt = 0; tt < 2; ++tt) { uint2 o; o.x = pk2h(Sacc[tt][0], Sacc[tt][1]); o.y = pk2h(Sacc[tt][2], Sacc[tt][3]);
                *(uint2*)(stn + (16 * ct + r16) * DS_PITCH + (32 * rt + 16 * tt + 4 * q4) * 2) = o; }
            __syncthreads();
            if (ch % 12 == 11) {
                const float* obf = (const float*)(smem + D_OB);
#pragma unroll 2
                for (int i = 0; i < 6; ++i) { const int idx = tid + i * NTHR, pos = idx >> 2, seg = idx & 3;
                    const float4 v0 = *(const float4*)(obf + pos * 32 + seg * 8), v1 = *(const float4*)(obf + pos * 32 + seg * 8 + 4);
                    uint4 o; o.x = pk2h(v0.x, v0.y); o.y = pk2h(v0.z, v0.w); o.z = pk2h(v1.x, v1.y); o.w = pk2h(v1.z, v1.w);
                    *(uint4*)(ODN + ((size_t)dir * T_ALL + seq_row(b, dir, (ch - 11) * 64 + pos)) * 512 + h * 128 + sl * 32 + seg * 8) = o; }
            }
        }
    }
#undef DC_CIDX
#undef DC_LOAD
}

DI bf16x8 pack_step(const f32x16& x, int s) {
    u32x4 q;
    asm volatile("v_cvt_pk_bf16_f32 %0, %4, %5\n\tv_cvt_pk_bf16_f32 %1, %6, %7\n\tv_cvt_pk_bf16_f32 %2, %8, %9\n\tv_cvt_pk_bf16_f32 %3, %10, %11\n\ts_nop 1"
                 : "=&v"(q[0]), "=&v"(q[1]), "=&v"(q[2]), "=&v"(q[3])
                 : "v"(x[8 * s]), "v"(x[8 * s + 1]), "v"(x[8 * s + 2]), "v"(x[8 * s + 3]), "v"(x[8 * s + 4]), "v"(x[8 * s + 5]), "v"(x[8 * s + 6]), "v"(x[8 * s + 7]));
    return __builtin_bit_cast(bf16x8, q);
}
constexpr int KPITCH = 272, VPITCH = 136, KBUF_B = 64 * KPITCH, VBUF_B = 128 * VPITCH;
DI void phase_attn(PrmC p, int ai, int layer, int n_items, unsigned char* smem) {
    const bf16_t* QD = (const bf16_t*)(p->ws + OFF_QD); const bf16_t* KD = (const bf16_t*)(p->ws + OFF_KD); const bf16_t* VT = (const bf16_t*)(p->ws + OFF_VT);
    bf16_t* Y = (bf16_t*)(p->ws + OFF_HY);
    const int tid = opaque_tid(), lane = tid & 63, wave = tid >> 6, qg = wave & 3, map = wave >> 2, r = lane & 31, hh = lane >> 5;
    asm volatile("" : "+s"(layer));
    float lam_full; const float lambda_init = 0.8f - 0.6f * __expf(-0.3f * (float)layer);
    { const float* lm = p->diff_lambda + (size_t)ai * 256; const float s1 = wave_sum(lm[lane] * lm[64 + lane]), s2 = wave_sum(lm[128 + lane] * lm[192 + lane]);
      lam_full = __expf(s1) - __expf(s2) + lambda_init; }
    unsigned char* kb0 = smem; unsigned char* vb0 = smem + 2 * KBUF_B;
    float* xch = (float*)smem;
    for (int item0 = bid(); item0 < n_items; item0 += gdim()) {
        int item = item0;
        if (gdim() == 256 && item0 < 512) { const int blk = item0 & 255, li = (item0 >> 8) * 32 + (blk >> 3); item = (((blk & 7) * 4 + (li >> 4)) << 4) + (li & 15); }
        int b, h, qpos0, nkt;
        if (item < 512) { b = item >> 6; h = (item >> 4) & 3; qpos0 = 256 + (item & 15) * 128; nkt = 36; }
        else { const int j = item - 512; b = j >> 3; h = (j >> 1) & 3; qpos0 = (j & 1) * 128; nkt = 4; }
        const int bh = b * 4 + h;
        const bf16_t* Kg = KD + (size_t)bh * 2304 * 128; const bf16_t* Vg = VT + (size_t)bh * 128 * 2304;
        bf16x8 qf[4];
        { const bf16_t* qp = QD + ((size_t)bh * 2304 + qpos0 + 32 * qg + r) * 128 + map * 64 + 8 * hh;
#pragma unroll
          for (int ks = 0; ks < 4; ++ks) qf[ks] = *(const bf16x8*)(qp + 16 * ks); }
        f32x16 O[4];
#pragma unroll
        for (int nt = 0; nt < 4; ++nt)
#pragma unroll
            for (int i = 0; i < 16; ++i) O[nt][i] = 0.f;
        float m = -1e30f, lsum = 0.f;
        uint4 kreg0, kreg1, vreg0, vreg1;
#define ATT_G1(i_, KR_, VR_, kt) { const int idx_ = tid + (i_) * NTHR; \
            KR_ = *(const uint4*)(Kg + (size_t)((kt) * 64 + (idx_ >> 4)) * 128 + (idx_ & 15) * 8); \
            VR_ = *(const uint4*)(Vg + (size_t)(idx_ >> 3) * 2304 + (kt) * 64 + (idx_ & 7) * 8); }
#define ATT_GLOAD(kt) do { ATT_G1(0, kreg0, vreg0, kt) ATT_G1(1, kreg1, vreg1, kt) } while (0)
#define ATT_S1(i_, KR_, VR_, bi) { const int idx_ = tid + (i_) * NTHR; \
            *(uint4*)(kb0 + (bi) * KBUF_B + (idx_ >> 4) * KPITCH + (idx_ & 15) * 16) = KR_; \
            *(uint2*)(vb0 + (bi) * VBUF_B + (idx_ >> 3) * VPITCH + (idx_ & 7) * 16) = make_uint2(VR_.x, VR_.y); *(uint2*)(vb0 + (bi) * VBUF_B + (idx_ >> 3) * VPITCH + (idx_ & 7) * 16 + 8) = make_uint2(VR_.z, VR_.w); }
#define ATT_LSTORE(bi) do { ATT_S1(0, kreg0, vreg0, bi) ATT_S1(1, kreg1, vreg1, bi) } while (0)
        __syncthreads();
        ATT_GLOAD(0); ATT_LSTORE(0);
        __syncthreads();
        for (int kt = 0; kt < nkt; ++kt) {
            const unsigned char* kb = kb0 + (kt & 1) * KBUF_B; const unsigned char* vb = vb0 + (kt & 1) * VBUF_B;
            if (kt + 1 < nkt) ATT_GLOAD(kt + 1);
            {
                f32x16 S0, S1;
#pragma unroll
                for (int i = 0; i < 16; ++i) { S0[i] = 0.f; S1[i] = 0.f; }
#pragma unroll
                for (int ks = 0; ks < 4; ++ks) {
                    const bf16x8 a0 = *(const bf16x8*)(kb + r * KPITCH + map * 128 + (16 * ks + 8 * hh) * 2);
                    const bf16x8 a1 = *(const bf16x8*)(kb + (32 + r) * KPITCH + map * 128 + (16 * ks + 8 * hh) * 2);
                    S0 = MFMA32(a0, qf[ks], S0); S1 = MFMA32(a1, qf[ks], S1); }
                float tmax = fmaxf(S0[0], S1[0]);
#pragma unroll
                for (int i = 1; i < 16; ++i) tmax = fmaxf(tmax, fmaxf(S0[i], S1[i]));
                if (__any(tmax > m + 8.0f)) {
                    tmax = fmaxf(tmax, __shfl_xor(tmax, 32));
                    const float mn = fmaxf(m, tmax), alpha = __builtin_amdgcn_exp2f(m - mn);
                    m = mn; lsum *= alpha;
#pragma unroll
                    for (int nt = 0; nt < 4; ++nt)
#pragma unroll
                        for (int i = 0; i < 16; ++i) O[nt][i] *= alpha;
                }
#pragma unroll
                for (int i = 0; i < 16; ++i) { S0[i] = __builtin_amdgcn_exp2f(S0[i] - m); S1[i] = __builtin_amdgcn_exp2f(S1[i] - m); lsum += S0[i] + S1[i]; }
#pragma unroll
                for (int sub = 0; sub < 2; ++sub)
#pragma unroll
                    for (int s = 0; s < 2; ++s) {
                        const bf16x8 pb = pack_step(sub ? S1 : S0, s);
#pragma unroll
                        for (int nt = 0; nt < 4; ++nt) {
                            const unsigned char* va = vb + (32 * nt + r) * VPITCH + (32 * sub + 16 * s + 4 * hh) * 2;
                            const uint2 lo = *(const uint2*)va, hi = *(const uint2*)(va + 16);
                            const uint4 av = make_uint4(lo.x, lo.y, hi.x, hi.y);
                            O[nt] = MFMA32(__builtin_bit_cast(bf16x8, av), pb, O[nt]);
                        }
                    }
            }
            if (kt + 1 < nkt) ATT_LSTORE((kt + 1) & 1);
            __syncthreads();
        }
        lsum += __shfl_xor(lsum, 32);
        const float inv = 1.0f / lsum;
        if (map == 1) {
            const float sc = lam_full * inv;
#pragma unroll
            for (int nt = 0; nt < 4; ++nt)
#pragma unroll
                for (int i = 0; i < 16; ++i) xch[(qg * 128 + 32 * nt + (i & 3) + 8 * (i >> 2) + 4 * hh) * 32 + r] = O[nt][i] * sc;
        }
        __syncthreads();
        if (map == 0) {
            float ss = 0.f;
#pragma unroll
            for (int nt = 0; nt < 4; ++nt)
#pragma unroll
                for (int i = 0; i < 16; ++i) { const float o = O[nt][i] * inv - xch[(qg * 128 + 32 * nt + (i & 3) + 8 * (i >> 2) + 4 * hh) * 32 + r]; O[nt][i] = o; ss += o * o; }
            ss += __shfl_xor(ss, 32);
            const float rstd = rsqrtf(ss * (1.0f / 128.0f) + 1e-6f) * (1.0f - lambda_init);
            const int pos = qpos0 + 32 * qg + r;
            const int row = pos >= 256 ? b * 2048 + (pos - 256) : T_LAT + b * 256 + pos;
            const float* sw = p->diff_subln_w + (size_t)ai * 128;
            bf16_t* yo = row < T_LAT ? Y + (size_t)row * 1024 + 512 + h * 128 : Y + (size_t)T_LAT * 1024 + ((size_t)2048 + (row - T_LAT)) * 512 + h * 128;
#pragma unroll
            for (int nt = 0; nt < 4; ++nt)
#pragma unroll
                for (int g4 = 0; g4 < 4; ++g4) { const int dv = 32 * nt + 8 * g4 + 4 * hh; const float4 w = *(const float4*)(sw + dv);
                    uint2 o; o.x = pk2(O[nt][4 * g4 + 0] * rstd * w.x, O[nt][4 * g4 + 1] * rstd * w.y); o.y = pk2(O[nt][4 * g4 + 2] * rstd * w.z, O[nt][4 * g4 + 3] * rstd * w.w);
                    *(uint2*)(yo + dv) = o; }
        }
    }
#undef ATT_GLOAD
#undef ATT_LSTORE
}

DI void phase_dn_merge(PrmC p, int ai, int nrows, int gw, int NGW) {
    const bf16_t* ODN = (const bf16_t*)(p->ws + OFF_ODN); const bf16_t* P = (const bf16_t*)(p->ws + OFF_ABP); bf16_t* Y = (bf16_t*)(p->ws + OFF_HY);
    const int lane = opaque_tid() & 63;
    const float* nw = p->dn_norm_w + (size_t)ai * 128 + (lane & 15) * 8;
    const float4 w0 = *(const float4*)nw, w1 = *(const float4*)(nw + 4);
    const float wv[8] = {w0.x, w0.y, w0.z, w0.w, w1.x, w1.y, w1.z, w1.w};
    for (int rowa = gw; rowa < nrows; rowa += 2 * NGW) {
        const int rowb = rowa + NGW < nrows ? rowa + NGW : rowa;
        const uint4 a0 = *(const uint4*)(ODN + (size_t)rowa * 512 + lane * 8), a1 = *(const uint4*)(ODN + ((size_t)T_ALL + rowa) * 512 + lane * 8), za = *(const uint4*)(P + (size_t)rowa * 3840 + 1536 + lane * 8);
        const uint4 b0 = *(const uint4*)(ODN + (size_t)rowb * 512 + lane * 8), b1 = *(const uint4*)(ODN + ((size_t)T_ALL + rowb) * 512 + lane * 8), zb = *(const uint4*)(P + (size_t)rowb * 3840 + 1536 + lane * 8);
#pragma unroll
        for (int rr = 0; rr < 2; ++rr) {
            const int row = rr ? rowb : rowa;
            float o[8], o2[8], z[8]; unpack8(rr ? b0 : a0, o); unpack8(rr ? b1 : a1, o2); unpack8(rr ? zb : za, z);
            float ss = 0.f;
#pragma unroll
            for (int e = 0; e < 8; ++e) { o[e] += o2[e]; ss += o[e] * o[e]; }
            ss = sum16(ss);
            const float rstd = rsqrtf(ss * (1.0f / 128.0f) + 1e-6f);
            float y[8];
#pragma unroll
            for (int e = 0; e < 8; ++e) y[e] = o[e] * rstd * wv[e] * silu_f(z[e]);
            *(uint4*)(row < T_LAT ? Y + (size_t)row * 1024 + lane * 8 : Y + (size_t)T_LAT * 1024 + (size_t)(row - T_LAT) * 512 + lane * 8) = pack8(y);
        }
    }
}

DI void phase_ret_prep(PrmC p, int ri, unsigned char* smem) {
    const bf16_t* P0 = (const bf16_t*)(p->ws + OFF_RP); const bf16_t* P1 = P0 + RP_STRIDE;
    bf16_t* QR = (bf16_t*)(p->ws + OFF_QR); bf16_t* KR = (bf16_t*)(p->ws + OFF_KR);
    bf16_t* KDT = (bf16_t*)(p->ws + OFF_KDT); bf16_t* VTR = (bf16_t*)(p->ws + OFF_VTR);
    const float2* RT = (const float2*)(p->ws + OFF_ROPE_RET);
    bf16_t* kt_l = (bf16_t*)smem;
    bf16_t* vt_l = (bf16_t*)(smem + 64 * 528);
    float* dec_l = (float*)(smem + 64 * 528 + 64 * 1040);
    const int tid = opaque_tid(), lane = tid & 63, wave = tid >> 6;
    for (int item = bid(); item < 288 * 4; item += gdim()) {
        const int g = item >> 2, hp = item & 3, row0 = g * 64; const bool lat = row0 < T_LAT;
        __syncthreads();
#pragma unroll
        for (int i = 0; i < 8; ++i) { const int idx = tid + i * NTHR, pos = idx >> 6, seg = idx & 63;
            *(uint4*)(vt_l + pos * 520 + seg * 8) = *(const uint4*)(P1 + (size_t)(row0 + pos) * 2048 + hp * 512 + seg * 8); }
        if (tid < 256) { const int j = tid & 63, hh2 = (tid >> 6) & 1, dir2 = tid >> 7; const float dl = p->ret_decay_logit[(size_t)ri * 16 + dir2 * 8 + 2 * hp + hh2];
            dec_l[tid] = exp2f(-log1pf(__expf(-dl)) * 1.4426950408889634f * (float)(dir2 ? j : 63 - j)); }
        { const int l32 = lane & 31, c = l32 * 8, wo = c & 127; const bool firsth = wo < 64;
#pragma unroll 2
          for (int tp = 0; tp < 4; ++tp) {
              const int pos = 8 * wave + 2 * tp + (lane >> 5), row = row0 + pos;
              float q[8], k[8]; unpack8(*(const uint4*)(P0 + (size_t)row * 2048 + hp * 256 + c), q); unpack8(*(const uint4*)(P0 + (size_t)row * 2048 + 1024 + hp * 256 + c), k);
              if (lat) {
                  const float2* rt = RT + (size_t)(row & 2047) * 64 + (wo & 63);
#pragma unroll
                  for (int e = 0; e < 8; ++e) { const float2 cs = rt[e]; const float qp = __shfl_xor(q[e], 8), kp = __shfl_xor(k[e], 8);
                      q[e] = q[e] * cs.x + (firsth ? -qp : qp) * cs.y; k[e] = k[e] * cs.x + (firsth ? -kp : kp) * cs.y; }
              }
#pragma unroll
              for (int e = 0; e < 8; ++e) k[e] *= 0.08838834764831845f;
              const uint4 kq = pack8(k);
              *(uint4*)(QR + (size_t)row * 1024 + hp * 256 + c) = pack8(q); *(uint4*)(KR + (size_t)row * 1024 + hp * 256 + c) = kq;
              *(uint4*)(kt_l + pos * 264 + c) = kq;
          } }
        __syncthreads();
#pragma unroll 2
        for (int i = 0; i < 8; ++i) {
            const int q = tid + i * NTHR, dk = q & 127, pg = (q >> 7) & 7, hh = (q >> 10) & 1, dir = (q >> 11) & 1, h = 2 * hp + hh;
            float v[8];
#pragma unroll
            for (int e = 0; e < 8; ++e) { const int j = 8 * pg + e; v[e] = bf2f(kt_l[j * 264 + hh * 128 + dk]) * dec_l[(dir * 2 + hh) * 64 + j]; }
            *(uint4*)(KDT + ((((size_t)dir * 288 + g) * 8 + h) * 128 + dk) * 64 + 8 * pg) = pack8(v);
        }
#pragma unroll 2
        for (int i = 0; i < 8; ++i) {
            const int q = tid + i * NTHR, dvi = q & 255, pg = (q >> 8) & 7, hh = q >> 11, h = 2 * hp + hh;
            unsigned w[4];
#pragma unroll
            for (int e = 0; e < 4; ++e) w[e] = (unsigned)vt_l[(8 * pg + 2 * e) * 520 + hh * 256 + dvi] | ((unsigned)vt_l[(8 * pg + 2 * e + 1) * 520 + hh * 256 + dvi] << 16);
            *(uint4*)(VTR + (((size_t)g * 8 + h) * 256 + dvi) * 64 + 8 * pg) = make_uint4(w[0], w[1], w[2], w[3]);
        }
    }
}

constexpr int RQ_PITCH = 272, RT_PITCH = 144;
constexpr int R_QL = 0, R_KL = 64 * RQ_PITCH, R_KTL = 2 * 64 * RQ_PITCH, R_VTL = R_KTL + 128 * RT_PITCH, R_ST = R_VTL + 128 * RT_PITCH;
DI void phase_ret_chunk(PrmC p, int ri, unsigned char* smem, bool skip_ctx_out) {
    const bf16_t* QR = (const bf16_t*)(p->ws + OFF_QR); const bf16_t* KR = (const bf16_t*)(p->ws + OFF_KR);
    const bf16_t* KDT = (const bf16_t*)(p->ws + OFF_KDT); const bf16_t* VTR = (const bf16_t*)(p->ws + OFF_VTR);
    bf16_t* ORp = (bf16_t*)(p->ws + OFF_OR);
    const int tid = opaque_tid(), lane = tid & 63, wave = tid >> 6, r = lane & 31, hh = lane >> 5;
    const int dvt = wave >> 1, it = wave & 1, dkt = wave >> 1, dv2 = 2 * (wave & 1);
    typedef __attribute__((address_space(3))) unsigned char* lbp;
    unsigned stb_ = R_ST; asm volatile("" : "+v"(stb_)); const lbp stl = (lbp)(uintptr_t)stb_;
    for (int item0 = bid(); item0 < 256; item0 += gdim()) {
        const int item = xcd_group_item(item0, gdim());
        const int sl = item & 1, dir = (item >> 1) & 1, h = (item >> 2) & 7, b = item >> 5;
        const float dl = p->ret_decay_logit[(size_t)ri * 16 + dir * 8 + h];
        const float lg2 = -log1pf(__expf(-dl)) * 1.4426950408889634f;
        const float cdec = exp2f(lg2 * 64.0f);
        const int ii = 32 * it + r;
        const float rowscale = exp2f(lg2 * (float)(dir ? 64 - ii : ii + 1));
        __attribute__((address_space(3))) float* gtab = (__attribute__((address_space(3))) float*)(stl + 128 * RQ_PITCH);
        __syncthreads();
        if (tid < 32) { const int rg = tid & 15, h2 = tid >> 4, jl = (rg & 3) + 8 * (rg >> 2) + 4 * h2; gtab[tid] = exp2f(lg2 * (float)(dir ? jl : -jl)); }
        const float gi0 = exp2f(lg2 * (float)(dir ? -ii : ii)), gi1 = gi0 * exp2f(lg2 * (dir ? 32.0f : -32.0f));
        f32x16 Sacc[2];
#pragma unroll
        for (int t = 0; t < 2; ++t)
#pragma unroll
            for (int i = 0; i < 16; ++i) Sacc[t][i] = 0.f;
        uint4 q0, q1, k0, k1, t0, t1, v0, v1;
#define RC_ROW0(ch) ((ch) < 4 ? T_LAT + b * 256 + (dir ? 3 - (ch) : (ch)) * 64 : b * 2048 + (dir ? 35 - (ch) : (ch) - 4) * 64)
#define RC_GLOAD(ch) do { const int row0_ = RC_ROW0(ch), g_ = row0_ >> 6; \
            { const int idx_ = tid, pos_ = idx_ >> 4, seg_ = idx_ & 15; q0 = *(const uint4*)(QR + (size_t)(row0_ + pos_) * 1024 + h * 128 + seg_ * 8); k0 = *(const uint4*)(KR + (size_t)(row0_ + pos_) * 1024 + h * 128 + seg_ * 8); } \
            { const int idx_ = tid + NTHR, pos_ = idx_ >> 4, seg_ = idx_ & 15; q1 = *(const uint4*)(QR + (size_t)(row0_ + pos_) * 1024 + h * 128 + seg_ * 8); k1 = *(const uint4*)(KR + (size_t)(row0_ + pos_) * 1024 + h * 128 + seg_ * 8); } \
            { const bf16_t* kd_ = KDT + (((size_t)dir * 288 + g_) * 8 + h) * 8192; const bf16_t* vt_ = VTR + (((size_t)g_ * 8 + h) * 256 + sl * 128) * 64; \
              t0 = *(const uint4*)(kd_ + tid * 8); t1 = *(const uint4*)(kd_ + (tid + NTHR) * 8); v0 = *(const uint4*)(vt_ + tid * 8); v1 = *(const uint4*)(vt_ + (tid + NTHR) * 8); } } while (0)
#define RC_LSTORE() do { \
            { const int idx_ = tid, pos_ = idx_ >> 4, seg_ = idx_ & 15; *(uint4*)(smem + R_QL + pos_ * RQ_PITCH + seg_ * 16) = q0; *(uint4*)(smem + R_KL + pos_ * RQ_PITCH + seg_ * 16) = k0; } \
            { const int idx_ = tid + NTHR, pos_ = idx_ >> 4, seg_ = idx_ & 15; *(uint4*)(smem + R_QL + pos_ * RQ_PITCH + seg_ * 16) = q1; *(uint4*)(smem + R_KL + pos_ * RQ_PITCH + seg_ * 16) = k1; } \
            { const int idx_ = tid, rw_ = idx_ >> 3, seg_ = idx_ & 7; *(uint4*)(smem + R_KTL + rw_ * RT_PITCH + seg_ * 16) = t0; *(uint4*)(smem + R_VTL + rw_ * RT_PITCH + seg_ * 16) = v0; } \
            { const int idx_ = tid + NTHR, rw_ = idx_ >> 3, seg_ = idx_ & 7; *(uint4*)(smem + R_KTL + rw_ * RT_PITCH + seg_ * 16) = t1; *(uint4*)(smem + R_VTL + rw_ * RT_PITCH + seg_ * 16) = v1; } } while (0)
        __syncthreads();
        for (int i = tid; i < 128 * RQ_PITCH / 16; i += NTHR) *(__attribute__((address_space(3))) u32x4*)(stl + i * 16) = (u32x4){0u, 0u, 0u, 0u};
        RC_GLOAD(0);
        for (int ch = 0; ch < 36; ++ch) {
            RC_LSTORE();
            __syncthreads();
            const int row0 = RC_ROW0(ch);
            if (ch + 1 < 36) RC_GLOAD(ch + 1);
            if (!(skip_ctx_out && ch < 4)) {
            int iil = ii; asm volatile("" : "+v"(iil));
            const bool use0 = dir ? (it == 0) : true, use1 = dir ? true : (it == 1);
            f32x16 acc, Sx0, Sx1;
#pragma unroll
            for (int i = 0; i < 16; ++i) { acc[i] = 0.f; Sx0[i] = 0.f; Sx1[i] = 0.f; }
#pragma unroll
            for (int ks = 0; ks < 8; ++ks) {
                const bf16x8 qf = *(const bf16x8*)(smem + R_QL + ii * RQ_PITCH + (16 * ks + 8 * hh) * 2);
                const bf16x8 a = *(const __attribute__((address_space(3))) bf16x8*)(stl + (32 * dvt + r) * RQ_PITCH + (16 * ks + 8 * hh) * 2);
                acc = MFMA32(a, qf, acc);
                if (use0) { const bf16x8 k0f = *(const bf16x8*)(smem + R_KL + r * RQ_PITCH + (16 * ks + 8 * hh) * 2); Sx0 = MFMA32(k0f, qf, Sx0); }
                if (use1) { const bf16x8 k1f = *(const bf16x8*)(smem + R_KL + (32 + r) * RQ_PITCH + (16 * ks + 8 * hh) * 2); Sx1 = MFMA32(k1f, qf, Sx1); }
            }
#pragma unroll
            for (int i = 0; i < 16; ++i) acc[i] *= rowscale;
            if (use0) {
#pragma unroll
                for (int i = 0; i < 16; ++i) { const int j = (i & 3) + 8 * (i >> 2) + 4 * hh; const bool keep = dir ? (j >= iil) : (iil >= j); Sx0[i] = keep ? Sx0[i] * (gi0 * gtab[hh * 16 + i]) : 0.f; }
#pragma unroll
                for (int s = 0; s < 2; ++s) {
                    const bf16x8 pb = pack_step(Sx0, s);
                    const unsigned char* va = smem + R_VTL + (32 * dvt + r) * RT_PITCH + (16 * s + 4 * hh) * 2;
                    const uint2 lo = *(const uint2*)va, hi = *(const uint2*)(va + 16);
                    acc = MFMA32(__builtin_bit_cast(bf16x8, make_uint4(lo.x, lo.y, hi.x, hi.y)), pb, acc);
                }
            }
            if (use1) {
#pragma unroll
                for (int i = 0; i < 16; ++i) { const int j = 32 + (i & 3) + 8 * (i >> 2) + 4 * hh; const bool keep = dir ? (j >= iil) : (iil >= j); Sx1[i] = keep ? Sx1[i] * (gi1 * gtab[hh * 16 + i]) : 0.f; }
#pragma unroll
                for (int s = 0; s < 2; ++s) {
                    const bf16x8 pb = pack_step(Sx1, s);
                    const unsigned char* va = smem + R_VTL + (32 * dvt + r) * RT_PITCH + (32 + 16 * s + 4 * hh) * 2;
                    const uint2 lo = *(const uint2*)va, hi = *(const uint2*)(va + 16);
                    acc = MFMA32(__builtin_bit_cast(bf16x8, make_uint4(lo.x, lo.y, hi.x, hi.y)), pb, acc);
                }
            }
            { bf16_t* op = ORp + ((size_t)dir * T_ALL + row0 + ii) * 2048 + h * 256 + sl * 128 + 32 * dvt + 4 * hh;
#pragma unroll
              for (int g4 = 0; g4 < 4; ++g4) { uint2 o; o.x = cvt_pk_bf16(acc[4 * g4], acc[4 * g4 + 1]); o.y = cvt_pk_bf16(acc[4 * g4 + 2], acc[4 * g4 + 3]); *(uint2*)(op + 8 * g4) = o; } }
            }
#pragma unroll
            for (int t = 0; t < 2; ++t) {
#pragma unroll
                for (int i = 0; i < 16; ++i) Sacc[t][i] *= cdec;
#pragma unroll
                for (int ks = 0; ks < 4; ++ks) {
                    const bf16x8 a = *(const bf16x8*)(smem + R_KTL + (32 * dkt + r) * RT_PITCH + (16 * ks + 8 * hh) * 2);
                    const bf16x8 bb = *(const bf16x8*)(smem + R_VTL + (32 * (dv2 + t) + r) * RT_PITCH + (16 * ks + 8 * hh) * 2);
                    Sacc[t] = MFMA32(a, bb, Sacc[t]);
                }
            }
            __syncthreads();
#pragma unroll
            for (int t = 0; t < 2; ++t)
#pragma unroll
                for (int g4 = 0; g4 < 4; ++g4) { u32x2_t o; o.x = cvt_pk_bf16(Sacc[t][4 * g4], Sacc[t][4 * g4 + 1]); o.y = cvt_pk_bf16(Sacc[t][4 * g4 + 2], Sacc[t][4 * g4 + 3]);
                    *(__attribute__((address_space(3))) u32x2_t*)(stl + (32 * (dv2 + t) + r) * RQ_PITCH + (32 * dkt + 8 * g4 + 4 * hh) * 2) = o; }
        }
    }
#undef RC_ROW0
#undef RC_GLOAD
#undef RC_LSTORE
}

DI void phase_ret_merge(PrmC p, int nrows, int gw, int NGW) {
    const bf16_t* ORp = (const bf16_t*)(p->ws + OFF_OR); const bf16_t* PG = (const bf16_t*)(p->ws + OFF_RP) + 2 * RP_STRIDE; bf16_t* Y = (bf16_t*)(p->ws + OFF_HY);
    const int lane = opaque_tid() & 63;
    for (int row = gw; row < nrows; row += NGW) {
        uint4 ra[4], rc[4], rz[4];
#pragma unroll
        for (int g = 0; g < 4; ++g) { const size_t off = (size_t)row * 2048 + g * 512 + lane * 8;
            ra[g] = *(const uint4*)(ORp + off); rc[g] = *(const uint4*)(ORp + (size_t)T_ALL * 2048 + off); rz[g] = *(const uint4*)(PG + off); }
#pragma unroll
        for (int g = 0; g < 4; ++g) {
            const size_t off = (size_t)row * 2048 + g * 512 + lane * 8;
            float a[8], c[8], z[8]; unpack8(ra[g], a); unpack8(rc[g], c); unpack8(rz[g], z);
            float ss = 0.f;
#pragma unroll
            for (int e = 0; e < 8; ++e) { a[e] += c[e]; ss += a[e] * a[e]; }
            ss = sum16(ss); ss += __shfl_xor(ss, 16);
            const float rstd = rsqrtf(ss * (1.0f / 256.0f) + 1e-6f);
#pragma unroll
            for (int e = 0; e < 8; ++e) a[e] = a[e] * rstd * silu_f(z[e]);
            *(uint4*)(row < T_LAT ? Y + off : Y + (size_t)T_LAT * 2048 + ((size_t)(g >> 1) * 2048 + (row - T_LAT)) * 1024 + (g & 1) * 512 + lane * 8) = pack8(a);
        }
    }
}

DI void phase_final(PrmC p, int gw, int NGW) {
    const float* X = (const float*)(p->ws + OFF_X);
    const int lane = opaque_tid() & 63;
    for (int row = gw; row < T_LAT; row += NGW) {
        const float* xr = X + (size_t)row * 1024;
        float4 v[4]; float ss = 0.f;
#pragma unroll
        for (int j = 0; j < 4; ++j) { v[j] = *(const float4*)(xr + j * 256 + lane * 4); ss += v[j].x * v[j].x + v[j].y * v[j].y + v[j].z * v[j].z + v[j].w * v[j].w; }
        const float rstd = rsqrtf(wave_sum(ss) * (1.0f / 1024.0f) + 1e-6f);
#pragma unroll
        for (int j = 0; j < 4; ++j) { const int c = j * 256 + lane * 4; const float4 w = *(const float4*)(p->final_norm_w + c);
            *(float4*)(p->out + (size_t)row * 1024 + c) = make_float4(v[j].x * rstd * w.x, v[j].y * rstd * w.y, v[j].z * rstd * w.z, v[j].w * rstd * w.w); }
    }
}


#define LAS __attribute__((address_space(3)))
#define XB_TMO      128
#define XB_XCNT(j)  (256  + 64 * (j))
#define XB_XSUB(j)  (1280 + 64 * (j))
#define XB_XGEN(j)  (2304 + 64 * (j))
#define XB_TOP      3328
#define XB_TOPGEN   3392
#define XCD_BAR_WORDS 3456
#define XB_SPIN_CAP (1u << 18)

__device__ __forceinline__ unsigned xb_ld(unsigned* p)              { return __hip_atomic_load(p, __ATOMIC_RELAXED, __HIP_MEMORY_SCOPE_AGENT); }
__device__ __forceinline__ unsigned xb_add(unsigned* p, unsigned v) { return __hip_atomic_fetch_add(p, v, __ATOMIC_RELAXED, __HIP_MEMORY_SCOPE_AGENT); }
__device__ __forceinline__ unsigned xb_xcc_id() { return (unsigned)__builtin_amdgcn_s_getreg((3 << 11) | 20) & 0xFu; }
#define XB_SPIN(cond, bar) do { unsigned _sp = 0; while (cond) { __builtin_amdgcn_s_sleep(1); \
    if ((++_sp & 255u) == 0u) { if (xb_ld(&(bar)[XB_TMO])) break; if (_sp > XB_SPIN_CAP) { atomicAdd(&(bar)[XB_TMO], 1u); break; } } } } while (0)

struct XcdBarrier {
    unsigned* bar; unsigned x;
    volatile LAS unsigned* st;
};

__device__ __forceinline__ XcdBarrier xcd_barrier_post(unsigned* bar, volatile LAS unsigned* st) {
    XcdBarrier b; b.bar = bar; b.x = xb_xcc_id(); b.st = st;
    if (threadIdx.x == 0) (void)xb_add(&bar[XB_XCNT(b.x)], 1u);
    return b;
}
__device__ __forceinline__ void xcd_barrier_complete(unsigned* bar, unsigned x, unsigned& nloc, unsigned& nx) {
    const unsigned G = gridDim.x * gridDim.y * gridDim.z;
    unsigned sum, cnt, mine, sp = 0u;
    for (;;) {
        sum = 0u; cnt = 0u; mine = 0u;
#pragma unroll
        for (unsigned j = 0; j < 16; ++j) { const unsigned c = xb_ld(&bar[XB_XCNT(j)]); sum += c; cnt += (c > 0u) ? 1u : 0u; mine = (j == x) ? c : mine; }
        if (sum == G) break;
        __builtin_amdgcn_s_sleep(1);
        if ((++sp & 255u) == 0u) { if (xb_ld(&bar[XB_TMO])) break; if (sp > XB_SPIN_CAP) { atomicAdd(&bar[XB_TMO], 1u); break; } }
    }
    nloc = mine > 0u ? mine : 1u; nx = cnt > 0u ? cnt : 1u;
}

__device__ __forceinline__ void xcd_barrier(const XcdBarrier& b) {
    asm volatile("s_waitcnt vmcnt(0)" ::: "memory");
    __syncthreads();
    if (threadIdx.x == 0) {
        unsigned* bar = b.bar;
        __builtin_amdgcn_s_waitcnt(0);
        unsigned nloc = b.st[0], nx = b.st[1];
        if (nloc == 0u) { xcd_barrier_complete(bar, b.x, nloc, nx); b.st[0] = nloc; b.st[1] = nx; }
        const unsigned old = xb_add(&bar[XB_XSUB(b.x)], 1u);
        const unsigned gen = old / nloc;
        if (old + 1u == (gen + 1u) * nloc) {
            __builtin_amdgcn_fence(__ATOMIC_RELEASE, "agent");
            asm volatile("s_waitcnt vmcnt(0)" ::: "memory");
            const unsigned og = xb_add(&bar[XB_TOP], 1u);
            const unsigned tg = og / nx;
            if (og + 1u == (tg + 1u) * nx) xb_add(&bar[XB_TOPGEN], 1u);
            else XB_SPIN(xb_ld(&bar[XB_TOPGEN]) == tg, bar);
            __builtin_amdgcn_fence(__ATOMIC_ACQUIRE, "agent");
            xb_add(&bar[XB_XGEN(b.x)], 1u);
            asm volatile("s_waitcnt vmcnt(0)" ::: "memory");
        } else {
            XB_SPIN(xb_ld(&bar[XB_XGEN(b.x)]) == gen, bar);
            __builtin_amdgcn_fence(__ATOMIC_ACQUIRE, "agent");
            asm volatile("s_waitcnt vmcnt(0)" ::: "memory");
        }
    }
    __syncthreads();
}


constexpr int LDS_BYTES = 152 * 1024;
#ifndef PROBE_ST5
#define PROBE_ST5 1
#endif
#ifndef PROBE_ST6
#define PROBE_ST6 1
#endif
#ifndef PROBE_ST7
#define PROBE_ST7 1
#endif
#ifndef PROBE_ST8
#define PROBE_ST8 1
#endif
DI int probe_n(int n) { asm volatile("" : "+s"(n)); return n; }
#define PROBE_LOOP(n) _Pragma("unroll 1") for (int rep_ = 0, nrep_ = ((n) > 1 ? probe_n(n) : 1); rep_ < nrep_; ++rep_)
constexpr int N_PHASES = 1 + 4 * 13 + 1;

__global__ void __launch_bounds__(NTHR, 2) fwd_megakernel(Prm p_unused, int lo, int hi) {
    extern __shared__ __attribute__((aligned(16))) unsigned char smem[];
    cg::grid_group grid = cg::this_grid();
    { const int t0 = opaque_tid(); if (t0 < 4) ((volatile LAS unsigned*)(LAS unsigned char*)(smem + LDS_BYTES - 16))[t0] = 0u; }
    __syncthreads();
    if (hi - lo > 1) { PrmC p0 = get_prm(); (void)xcd_barrier_post((unsigned*)(p0->ws + OFF_BAR), (volatile LAS unsigned*)(LAS unsigned char*)(smem + LDS_BYTES - 16)); }
#define PHASE_LOCALS const int wave = __builtin_amdgcn_readfirstlane(opaque_tid() >> 6); const int G = gdim(), gw = bid() * 8 + wave, NGW = G * 8; float* scr = (float*)smem + wave * (64 * 68); pg8_lds_t lds = (pg8_lds_t)smem; (void)scr; (void)lds; (void)gw; (void)NGW;
    int ph = 0;
#define RUN_PHASE (ph >= lo && ph < hi)
#define END_PHASE do { if (ph >= lo && ph + 1 < hi) { \
        if (ph == lo && hi > 4096) {   asm volatile("s_waitcnt vmcnt(0)" ::: "memory"); grid.sync(); __builtin_amdgcn_fence(__ATOMIC_ACQUIRE, "agent"); asm volatile("s_waitcnt vmcnt(0)" ::: "memory"); }   \
        else { PrmC pb_ = get_prm(); XcdBarrier xb_; xb_.bar = (unsigned*)(pb_->ws + OFF_BAR); xb_.x = xb_xcc_id(); xb_.st = (volatile LAS unsigned*)(LAS unsigned char*)(smem + LDS_BYTES - 16); xcd_barrier(xb_); } } ++ph; } while (0)

    if (RUN_PHASE) { PrmC p = get_prm(); phase_mod(p, smem); __syncthreads();
        PHASE_LOCALS int rot = 0;
        const int first_free = G > 176 ? 144 : 0, vb = bid() - first_free;
        if (vb >= 0) { const int gw2 = vb * 8 + wave, NGW2 = (G - first_free) * 8;
            convert_weights<1>(p->ffn_w_in, 1024, 5632, (bf16_t*)(p->ws + OFF_WFI), scr, gw2, NGW2, rot);
            convert_weights<0>(p->ffn_w_out, 2816, 1024, (bf16_t*)(p->ws + OFF_WFO), scr, gw2, NGW2, rot, 1408, (bf16_t*)(p->ws + OFF_WFOS));
            convert_weights<2>(p->ab_w_in, 1024, 3600, (bf16_t*)(p->ws + OFF_WMI), scr, gw2, NGW2, rot); } }
    END_PHASE;

#pragma unroll 1
    for (int l = 0; l < 4; ++l) {
        const bool is_ab = (l & 1) == 0; const int mi = l >> 1; const bool last = l == 3;
#pragma unroll 1
        for (int st = 0; st < 13; ++st) {
            if (st == 8 && !is_ab) continue;
            if (RUN_PHASE) {
#ifdef DUP_MASK
              for (int rep_ = 0; rep_ < (((DUP_MASK) >> st) & 1) + 1; ++rep_) {
                if (rep_) __syncthreads();
#endif
                PrmC p = get_prm();
                PHASE_LOCALS
                float* X = (float*)(p->ws + OFF_X); const float* MOD = (const float*)(p->ws + OFF_MOD); bf16_t* HY = (bf16_t*)(p->ws + OFF_HY);
                bf16_t* WFI = (bf16_t*)(p->ws + OFF_WFI); bf16_t* WFO = (bf16_t*)(p->ws + OFF_WFO); bf16_t* WMI = (bf16_t*)(p->ws + OFF_WMI); bf16_t* WMO = (bf16_t*)(p->ws + OFF_WMO);
                const int Mrows = (last && st >= 9) ? T_LAT : T_ALL;
                const bool x_from_input = (l == 0 && st <= 2);
                const float* xlat = x_from_input ? p->x : X; const float* xctx = (l == 0 && st <= 3) ? p->ctx : X + (size_t)T_LAT * 1024;
                if (st == 0 || st == 3 || st == 10) {
#ifdef PROBE_NORM
                  for (int rep_ = 0; rep_ < 2; ++rep_) {
#endif
                    int rot = 0;
                    const float* fixgate = st == 3 ? MOD + ((size_t)l * 9 + 8) * 9216 + 2 * 1024 : ((st == 0 && l > 0) ? MOD + ((size_t)(l - 1) * 9 + 8) * 9216 + 8 * 1024 : ((st == 10 && !last) ? MOD + ((size_t)l * 9 + 8) * 9216 + 5 * 1024 : nullptr));
                    norm_rows(p, xlat, xctx, l, st == 0 ? 0 : (st == 3 ? 1 : 2), Mrows, gw, NGW, rot, fixgate, st == 10 ? 1.0f : 0.5f);
#ifdef PROBE_NORM
                  }
#endif
                } else if (st == 1 || st == 11) {
                    pg8::Gemm g{HY, st == 1 ? WFI : (bf16_t*)(p->ws + OFF_WFI2), Mrows, 5632, 1024}; pg8::StaticOrder S; S.init(Mrows, 5632, G, bid());
                    pg8::EpiSwiglu E{(bf16_t*)(p->ws + OFF_HID), 2816, (bf16_t*)(p->ws + OFF_HIDC)};
                    pg8::gemm_phase<pg8::EpiSwiglu, pg8::StaticOrder, true, true>(lds, g, S, E);
                } else if (st == 2 || st == 9 || st == 12) {
                    const int sub = st == 2 ? 0 : (st == 9 ? 1 : 2);
                    const bf16_t* A = st == 9 ? HY : (const bf16_t*)(p->ws + OFF_HID);
                    const bf16_t* Bt = st == 9 ? WMO : (st == 2 ? WFO : (const bf16_t*)(p->ws + OFF_WFO2));
                    const int K = st == 9 ? (is_ab ? 1024 : 2048) : 2816;
                    const bool split = Mrows == T_ALL;
                    const int Mg = split ? T_LAT : Mrows;
                    pg8::Gemm g{A, Bt, Mg, 1024, K}; pg8::StaticOrder S; S.init(Mg, 1024, G, bid());
                    pg8::EpiResid E{xlat, xctx, X, MOD + (size_t)l * 9 * 9216 + (3 * sub + 2) * 1024, st == 9 ? 1.0f : 0.5f};
                    pg8::gemm_phase<pg8::EpiResid, pg8::StaticOrder, false, true>(lds, g, S, E);
                    if (split) {
                        const int Kh = K >> 1;
                        pg8::Gemm g2{st == 9 ? (const bf16_t*)HY + (size_t)T_LAT * K : (const bf16_t*)(p->ws + OFF_HIDC), (const bf16_t*)(p->ws + (st == 9 ? (is_ab ? OFF_WMOS_AB : OFF_WMOS_RET) : (st == 2 ? OFF_WFOS : OFF_WFOS2))), 4096, 2048, Kh}; pg8::CtxSplitOrder S2{G, bid()};
                        pg8::EpiPartial E2{(float*)(p->ws + OFF_PART)};
                        pg8::gemm_phase<pg8::EpiPartial, pg8::CtxSplitOrder, false, true>(lds, g2, S2, E2);
                    }
                    if (st == 2 || (st == 12 && !last)) {
                        const int first_idle = 64 % G, vb = bid() - first_idle;
                        if (vb >= 0) { const int gw2 = vb * 8 + wave, NGW2 = (G - first_idle) * 8; int rot = 0;
                            if (st == 2) {
                                convert_weights<1>(p->ffn_w_in + (size_t)(l * 2 + 1) * 1024 * 5632, 1024, 5632, (bf16_t*)(p->ws + OFF_WFI2), scr, gw2, NGW2, rot);
                                convert_weights<0>(p->ffn_w_out + (size_t)(l * 2 + 1) * 2816 * 1024, 2816, 1024, (bf16_t*)(p->ws + OFF_WFO2), scr, gw2, NGW2, rot, 1408, (bf16_t*)(p->ws + OFF_WFOS2));
                                if (is_ab) convert_weights<0>(p->ab_w_out + (size_t)mi * 1024 * 1024, 1024, 1024, WMO, scr, gw2, NGW2, rot, 512, (bf16_t*)(p->ws + OFF_WMOS_AB));
                                else convert_weights<0>(p->ret_w_out + (size_t)mi * 2048 * 1024, 2048, 1024, WMO, scr, gw2, NGW2, rot, 1024, last ? (bf16_t*)nullptr : (bf16_t*)(p->ws + OFF_WMOS_RET));
                            } else {
                                convert_weights<1>(p->ffn_w_in + (size_t)(l * 2 + 2) * 1024 * 5632, 1024, 5632, WFI, scr, gw2, NGW2, rot);
                                convert_weights<0>(p->ffn_w_out + (size_t)(l * 2 + 2) * 2816 * 1024, 2816, 1024, WFO, scr, gw2, NGW2, rot, 1408, (bf16_t*)(p->ws + OFF_WFOS));
                                if (!is_ab) convert_weights<2>(p->ab_w_in + (size_t)(mi + 1) * 1024 * 3600, 1024, 3600, WMI, scr, gw2, NGW2, rot);
                                else convert_weights<0>(p->ret_w_in + (size_t)mi * 1024 * 6144, 1024, 6144, WMI, scr, gw2, NGW2, rot);
                            } } }
                } else if (st == 4) {
                    const int N = is_ab ? 3840 : 6144;
                    pg8::Gemm g{HY, WMI, T_ALL, N, 1024}; pg8::StaticOrder S; S.init(T_ALL, N, G, bid());
                    pg8::EpiBf16 E{(bf16_t*)(p->ws + OFF_BIG), is_ab ? 3840 : 2048, is_ab ? 0 : 2048, is_ab ? (size_t)0 : RP_STRIDE};
                    pg8::gemm_phase<pg8::EpiBf16, pg8::StaticOrder, true, true>(lds, g, S, E);
                } else if (st == 5) {
                    PROBE_LOOP(PROBE_ST5) { if (is_ab) phase_ab_prep(p, mi, smem); else phase_ret_prep(p, mi, smem); }
                } else if (st == 6) {
                    PROBE_LOOP(PROBE_ST6) { if (is_ab) { const int extra = 576 % G;
                        phase_attn(p, mi, l, 576, smem); (void)extra; phase_dn_chunkprep(p, smem, bid(), G); }     else phase_ret_chunk(p, mi, smem, last); }
                } else if (st == 7) {
                    PROBE_LOOP(PROBE_ST7) { if (is_ab) phase_dn_chunkrec(p, smem); else phase_ret_merge(p, last ? T_LAT : T_ALL, gw, NGW); }
                } else if (st == 8) {
                    PROBE_LOOP(PROBE_ST8) { phase_dn_merge(p, mi, T_ALL, gw, NGW); }
                }
#ifdef DUP_MASK
              }
#endif
            }
            END_PHASE;
        }
        if (!is_ab) { ++ph; }
    }
    if (RUN_PHASE) { PrmC p = get_prm(); PHASE_LOCALS phase_final(p, gw, NGW); }
}

extern "C" void kernel_launch(void* const* d_in, const int* in_sizes, int n_in, void* d_out, int out_size, void* d_ws, size_t ws_size, hipStream_t stream) {
    static int grid_blocks = 0;
    if (grid_blocks == 0) {
        if (ws_size < WS_NEED) { fprintf(stderr, "kernel_launch: workspace too small: %zu < %zu\n", ws_size, (size_t)WS_NEED); grid_blocks = -1; return; }
        int dev = 0, cus = 0, per_cu = 0;
        hipGetDevice(&dev);
        hipDeviceGetAttribute(&cus, hipDeviceAttributeMultiprocessorCount, dev);
        if (hipFuncSetAttribute((const void*)fwd_megakernel, hipFuncAttributeMaxDynamicSharedMemorySize, LDS_BYTES) != hipSuccess) { fprintf(stderr, "kernel_launch: hipFuncSetAttribute failed\n"); grid_blocks = -1; return; }
        if (hipOccupancyMaxActiveBlocksPerMultiprocessor(&per_cu, (const void*)fwd_megakernel, NTHR, LDS_BYTES) != hipSuccess || per_cu < 1) { fprintf(stderr, "kernel_launch: occupancy query says %d\n", per_cu); per_cu = 1; (void)hipGetLastError(); }
        grid_blocks = cus * 1;
    }
    if (grid_blocks < 0) return;
    Prm p{};
    const float** pp = (const float**)&p;
    for (int i = 0; i < 21; ++i) pp[i] = (const float*)d_in[i];
    p.out = (float*)d_out; p.ws = (unsigned char*)d_ws;
    if (hipMemsetAsync((unsigned char*)d_ws + OFF_BAR, 0, SZ_BAR, stream) != hipSuccess) { fprintf(stderr, "kernel_launch: memset failed\n"); return; }
#if defined(MK_MULTI)
    for (int i = 0; i < N_PHASES; ++i) hipLaunchKernelGGL(fwd_megakernel, dim3(grid_blocks), dim3(NTHR), LDS_BYTES, stream, p, i, i + 1);
#else
    int lo = 0, hi = N_PHASES;
    void* args[] = {&p, &lo, &hi};
    hipError_t e = hipLaunchCooperativeKernel((const void*)fwd_megakernel, dim3(grid_blocks), dim3(NTHR), args, LDS_BYTES, stream);
    if (e != hipSuccess) fprintf(stderr, "cooperative launch failed: %s (grid %d)\n", hipGetErrorString(e), grid_blocks);
#endif
}
```

```cpp
#include <hip/hip_runtime.h>
#include <hip/hip_cooperative_groups.h>
#include <cstdio>
#include <cstdint>
namespace cg = cooperative_groups;

__device__ __forceinline__ int opaque_tid() { int t = threadIdx.x; asm volatile("" : "+v"(t)); return t; }
__device__ __forceinline__ int bid() { int b = blockIdx.x; asm volatile("" : "+s"(b)); return b; }
__device__ __forceinline__ int gdim() { int g = gridDim.x; asm volatile("" : "+s"(g)); return g; }
namespace pg8 {
#define PG8_LAS __attribute__((address_space(3)))
typedef unsigned short bf16_t;
typedef short bf16x8 __attribute__((ext_vector_type(8)));
typedef float f32x4 __attribute__((ext_vector_type(4)));
typedef unsigned u32x4 __attribute__((ext_vector_type(4)));
constexpr int BM = 256, BK = 64, HALF = 128, HTB = HALF * BK * 2  , STAGE_BYTES = 8 * HTB, NXCD = 8, WGM = 4;
__host__ __device__ __forceinline__ int lds_byte(int r, int c) { const int st = (r >> 4) * 2 + (c >> 5), rr = r & 15, cc = c & 31, ob = rr * 64 + cc * 2; return st * 1024 + (ob ^ (((ob >> 9) & 1) << 5)); }
__host__ __device__ __forceinline__ void stage_rc(int b, int& R, int& C) { const int st = b / 1024, sb = b % 1024, swz = sb ^ (((sb >> 9) & 1) << 5); R = (st >> 1) * 16 + swz / 64; C = (st & 1) * 32 + (swz % 64) / 2; }
__host__ __device__ __forceinline__ int perm32(int rho) { const int n = rho >> 4, i = rho & 15; return 8 * (i >> 2) + 4 * n + (i & 3); }

struct Unit { int pm, pn; };
struct Gemm { const bf16_t* A; const bf16_t* Bt; int M, N, K; };

struct StaticOrder {
    int nM, nN, nwg, G, c;
    __host__ __device__ void init(int M, int N, int G_, int c_) { nM = M / BM; nN = N / BM; nwg = nM * nN; G = G_; c = c_; }
    __host__ __device__ bool next(int i, Unit& u) const {
        const long L = (long)i * G + c; if (L >= nwg) return false;
        int wgid = (int)L; { const int q = nwg / NXCD, r = nwg % NXCD, xcd = wgid % NXCD, off = wgid / NXCD; wgid = (xcd < r ? xcd * (q + 1) : r * (q + 1) + (xcd - r) * q) + off; }
        const int nig = WGM * nN, gid = wgid / nig, fm = gid * WGM, gsz = (nM - fm) < WGM ? (nM - fm) : WGM;
        u.pm = fm + ((wgid % nig) % gsz); u.pn = (wgid % nig) / gsz; return true;
    }
    __device__ __forceinline__ void a_ready(const Unit&) const {}
    __device__ __forceinline__ void done(const Unit&) const {}
};

__device__ __forceinline__ unsigned cvt_pk_bf16(float lo, float hi) { unsigned r; asm volatile("v_cvt_pk_bf16_f32 %0, %1, %2" : "=v"(r) : "v"(lo), "v"(hi)); return r; }

__device__ __forceinline__ float fast_silu(float g) { return g * __builtin_amdgcn_rcpf(1.0f + __expf(-g)); }

struct EpiSwiglu {
    static constexpr bool PERM = true, AFTER_DRAIN = false;
    bf16_t* O; int ldc; bf16_t* OC;
    __device__ __forceinline__ void operator()(const f32x4 (&acc)[2][2][4][2], const Unit& u, int wr, int wc, int fr, int fq) const {
        const int row0 = u.pm * BM + wr * 64 + fr, col0 = u.pn * HALF + wc * 32 + 8 * fq;
        bf16_t* base = O + (size_t)row0 * ldc + col0; size_t pitch = (size_t)ldc;
        if (OC && u.pm >= 64) { const int kh = col0 >= 1408 ? 1 : 0; base = OC + ((size_t)kh * 2048 + (row0 - 16384)) * 1408 + (col0 - kh * 1408); pitch = 1408; }
#pragma unroll
        for (int ai = 0; ai < 2; ++ai)
#pragma unroll
            for (int m = 0; m < 4; ++m) { bf16_t* rowp = base + (size_t)(ai * HALF + m * 16) * pitch;
                const f32x4 g0 = acc[ai][0][m][0], g1 = acc[ai][0][m][1], u0 = acc[ai][1][m][0], u1 = acc[ai][1][m][1];
                float h[8];
#pragma unroll
                for (int j = 0; j < 4; ++j) { h[j] = fast_silu(g0[j]) * u0[j]; h[4 + j] = fast_silu(g1[j]) * u1[j]; }
                u32x4 w; w.x = cvt_pk_bf16(h[0], h[1]); w.y = cvt_pk_bf16(h[2], h[3]); w.z = cvt_pk_bf16(h[4], h[5]); w.w = cvt_pk_bf16(h[6], h[7]);
                *(u32x4*)rowp = w; }
    }
};
struct CtxSplitOrder {
    int G, c;
    __device__ bool next(int i, Unit& u) const { const int L = i * G + c; if (L >= 64) return false; const int kh = L >> 5, r = L & 31; u.pm = kh * 8 + (r >> 2); u.pn = kh * 4 + (r & 3); return true; }
    __device__ __forceinline__ void a_ready(const Unit&) const {}
    __device__ __forceinline__ void done(const Unit&) const {}
};
struct EpiPartial {
    static constexpr bool PERM = false, AFTER_DRAIN = false;
    float* P;
    __device__ __forceinline__ void operator()(const f32x4 (&acc)[2][2][4][2], const Unit& u, int wr, int wc, int fr, int fq) const {
        const int kh = u.pn >> 2, row0 = (u.pm & 7) * BM + wr * 64 + fr, col0 = (u.pn & 3) * BM + wc * 32 + 4 * fq;
        float* base = P + ((size_t)kh * 2048 + row0) * 1024 + col0;
#pragma unroll
        for (int ai = 0; ai < 2; ++ai)
#pragma unroll
            for (int m = 0; m < 4; ++m)
#pragma unroll
                for (int bj = 0; bj < 2; ++bj)
#pragma unroll
                    for (int n = 0; n < 2; ++n) *(f32x4*)(base + (size_t)(ai * HALF + m * 16) * 1024 + bj * HALF + n * 16) = acc[ai][bj][m][n];
    }
};
struct EpiResid {
    static constexpr bool PERM = false, AFTER_DRAIN = false;
    const float* xin_lat; const float* xin_ctx; float* xout; const float* gate; float s;
    __device__ __forceinline__ void operator()(const f32x4 (&acc)[2][2][4][2], const Unit& u, int wr, int wc, int fr, int fq) const {
        const int row0 = u.pm * BM + wr * 64 + fr, col0 = u.pn * BM + wc * 32 + 4 * fq;
        const int mr = u.pm < 64 ? (u.pm >> 3) : 8;
        f32x4 gv[2][2];
#pragma unroll
        for (int bj = 0; bj < 2; ++bj)
#pragma unroll
            for (int n = 0; n < 2; ++n) gv[bj][n] = *(const f32x4*)(gate + (size_t)mr * 9216 + col0 + bj * HALF + n * 16) * s;
#pragma unroll
        for (int ai = 0; ai < 2; ++ai) {
            f32x4 xv[4][2][2];
#pragma unroll
            for (int m = 0; m < 4; ++m) { const int row = row0 + ai * HALF + m * 16;
                const float* xi = row < 16384 ? xin_lat + (size_t)row * 1024 : xin_ctx + (size_t)(row - 16384) * 1024;
#pragma unroll
                for (int bj = 0; bj < 2; ++bj)
#pragma unroll
                    for (int n = 0; n < 2; ++n) xv[m][bj][n] = *(const f32x4*)(xi + col0 + bj * HALF + n * 16); }
            asm volatile("" ::: "memory");
#pragma unroll
            for (int m = 0; m < 4; ++m) { float* xo = xout + (size_t)(row0 + ai * HALF + m * 16) * 1024;
#pragma unroll
                for (int bj = 0; bj < 2; ++bj)
#pragma unroll
                    for (int n = 0; n < 2; ++n) *(f32x4*)(xo + col0 + bj * HALF + n * 16) = xv[m][bj][n] + gv[bj][n] * acc[ai][bj][m][n]; }
            asm volatile("" ::: "memory");
        }
    }
};
struct EpiBf16 {
    static constexpr bool PERM = true, AFTER_DRAIN = false;
    bf16_t* O; int ldc; int split_cols; size_t split_stride;
    __device__ __forceinline__ void operator()(const f32x4 (&acc)[2][2][4][2], const Unit& u, int wr, int wc, int fr, int fq) const {
        const int row0 = u.pm * BM + wr * 64 + fr; int colt = u.pn * BM; bf16_t* base = O;
        if (split_cols) { const int t = colt / split_cols; base += (size_t)t * split_stride; colt -= t * split_cols; }
        const int col0 = colt + wc * 32 + 8 * fq;
#pragma unroll
        for (int ai = 0; ai < 2; ++ai)
#pragma unroll
            for (int m = 0; m < 4; ++m) { bf16_t* rowp = base + (size_t)(row0 + ai * HALF + m * 16) * ldc + col0;
#pragma unroll
                for (int bj = 0; bj < 2; ++bj) { const f32x4 v0 = acc[ai][bj][m][0], v1 = acc[ai][bj][m][1];
                    u32x4 w; w.x = cvt_pk_bf16(v0[0], v0[1]); w.y = cvt_pk_bf16(v0[2], v0[3]); w.z = cvt_pk_bf16(v1[0], v1[1]); w.w = cvt_pk_bf16(v1[2], v1[3]);
                    *(u32x4*)(rowp + bj * HALF) = w; } }
    }
};

typedef PG8_LAS unsigned char* pg8_lds_t_;
template <class Epi, class Sched, bool ALIGN_EPI = false, bool SP2 = false>
__device__ __forceinline__ void gemm_phase(PG8_LAS unsigned char* lds, const Gemm g, const Sched& S, const Epi& E) {
    const int tid = opaque_tid(), wid = __builtin_amdgcn_readfirstlane(tid >> 6), lane = tid & 63, wr = wid >> 2, wc = wid & 3, fr = lane & 15, fq = lane >> 4;
    const int K = g.K, nt = K / BK;
    unsigned voffA[2], voffB[2];
#pragma unroll
    for (int i = 0; i < 2; ++i) { int R, C; stage_rc(tid * 16 + i * 8192, R, C); const int Rb = Epi::PERM ? ((R & ~31) + perm32(R & 31)) : R;
        voffA[i] = (unsigned)(R * K + C) * 2u; voffB[i] = (unsigned)(Rb * K + C) * 2u; }
    const size_t kstep = (size_t)(BK * 2);
    const size_t hstep = (size_t)HALF * K * 2;
    const size_t tstep = 2 * hstep;
    const unsigned ldsw = (unsigned)wid * 1024u;
    const int aoff = lds_byte(wr * 64 + fr, fq * 8), boff = lds_byte(wc * 32 + fr, fq * 8);
#define PG8_SA(b, h) (((b) * 2 + (h)) * HTB)
#define PG8_SB(b, h) ((4 + (b) * 2 + (h)) * HTB)
#define PG8_STAGE(bufoff, gbase, voff) do { _Pragma("unroll") for (int _i = 0; _i < 2; ++_i) \
        __builtin_amdgcn_global_load_lds((const unsigned*)((const char*)(gbase) + (voff)[_i]), (PG8_LAS unsigned*)(lds + (bufoff) + ldsw + _i * 8192), 16, 0, 0); } while (0)
#define PG8_LDA(dst, b, h) do { _Pragma("unroll") for (int m = 0; m < 4; ++m) _Pragma("unroll") for (int k = 0; k < 2; ++k) dst[m][k] = *(const PG8_LAS bf16x8*)(lds + PG8_SA(b, h) + aoff + m * 2048 + k * 1024); } while (0)
#define PG8_LDB(dst, b, h) do { _Pragma("unroll") for (int n = 0; n < 2; ++n) _Pragma("unroll") for (int k = 0; k < 2; ++k) dst[n][k] = *(const PG8_LAS bf16x8*)(lds + PG8_SB(b, h) + boff + n * 2048 + k * 1024); } while (0)
#define PG8_MMA(ai, bj, At, Bt) do { __builtin_amdgcn_s_setprio(1); _Pragma("unroll") for (int m = 0; m < 4; ++m) _Pragma("unroll") for (int n = 0; n < 2; ++n) _Pragma("unroll") for (int k = 0; k < 2; ++k) \
        acc[ai][bj][m][n] = __builtin_amdgcn_mfma_f32_16x16x32_bf16(Bt[n][k], At[m][k], acc[ai][bj][m][n], 0, 0, 0); __builtin_amdgcn_s_setprio(0); } while (0)
#define PG8_WAIT_V(n) asm volatile("s_waitcnt vmcnt(" #n ")" ::: "memory")
#define PG8_WAIT_L(n) asm volatile("s_waitcnt lgkmcnt(" #n ")" ::: "memory")
#define PG8_BAR __builtin_amdgcn_s_barrier()
#define PG8_SCHED __builtin_amdgcn_sched_barrier(0)
    Unit cur, nxt; int ui = 0;
    if (!S.next(0, cur)) return;
    f32x4 acc[2][2][4][2];
#pragma unroll
    for (int a = 0; a < 2; ++a)
#pragma unroll
        for (int b = 0; b < 2; ++b)
#pragma unroll
            for (int m = 0; m < 4; ++m)
#pragma unroll
                for (int n = 0; n < 2; ++n) acc[a][b][m][n] = (f32x4){0.f, 0.f, 0.f, 0.f};
    bf16x8 At[4][2], B0[2][2], B1[2][2];
    const char* cA = (const char*)g.A + (size_t)cur.pm * tstep; const char* cB = (const char*)g.Bt + (size_t)cur.pn * tstep;
    S.a_ready(cur);
    if constexpr (SP2) {
        PG8_STAGE(PG8_SB(0, 0), cB, voffB); PG8_STAGE(PG8_SB(0, 1), cB + hstep, voffB); PG8_STAGE(PG8_SA(0, 0), cA, voffA); PG8_STAGE(PG8_SA(0, 1), cA + hstep, voffA);
        if (wr == 1) PG8_BAR;
        PG8_WAIT_V(2); PG8_BAR;
        PG8_STAGE(PG8_SB(1, 0), cB + kstep, voffB); PG8_STAGE(PG8_SA(1, 0), cA + kstep, voffA); PG8_STAGE(PG8_SB(1, 1), cB + hstep + kstep, voffB);
        PG8_WAIT_V(6); PG8_BAR;
    } else {
        PG8_STAGE(PG8_SB(0, 0), cB, voffB); PG8_STAGE(PG8_SA(0, 0), cA, voffA); PG8_STAGE(PG8_SB(0, 1), cB + hstep, voffB); PG8_STAGE(PG8_SA(0, 1), cA + hstep, voffA);
        if (wr == 1) PG8_BAR;
        PG8_WAIT_V(4); PG8_BAR;
        PG8_STAGE(PG8_SB(1, 0), cB + kstep, voffB); PG8_STAGE(PG8_SA(1, 0), cA + kstep, voffA); PG8_STAGE(PG8_SB(1, 1), cB + hstep + kstep, voffB);
        PG8_WAIT_V(6); PG8_BAR;
    }
    for (;;) {
        const bool has_next = S.next(ui + 1, nxt);
        const char* nA = has_next ? (const char*)g.A + (size_t)nxt.pm * tstep : cA; const char* nB = has_next ? (const char*)g.Bt + (size_t)nxt.pn * tstep : cB;
        for (int t = 0; t < nt; t += 2) {
            const bool last = (t == nt - 2);
            const char* a1 = cA + (size_t)(t + 1) * kstep;
            const char* a2 = last ? nA : cA + (size_t)(t + 2) * kstep; const char* b2 = last ? nB : cB + (size_t)(t + 2) * kstep;
            const char* a3 = a2 + kstep; const char* b3 = b2 + kstep;
            if (last && has_next) S.a_ready(nxt);
            if constexpr (SP2) {
            PG8_LDB(B0, 0, 0); PG8_LDB(B1, 0, 1); PG8_SCHED; PG8_LDA(At, 0, 0); PG8_STAGE(PG8_SA(1, 1), a1 + hstep, voffA);
            PG8_WAIT_V(8); PG8_WAIT_L(0); PG8_BAR; PG8_MMA(0, 0, At, B0); PG8_MMA(0, 1, At, B1); PG8_BAR; PG8_SCHED;
            PG8_LDA(At, 0, 1); PG8_STAGE(PG8_SB(0, 0), b2, voffB); PG8_STAGE(PG8_SB(0, 1), b2 + hstep, voffB); PG8_STAGE(PG8_SA(0, 0), a2, voffA);
            PG8_WAIT_V(8); PG8_WAIT_L(0); PG8_BAR; PG8_MMA(1, 0, At, B0); PG8_MMA(1, 1, At, B1); PG8_BAR; PG8_SCHED;
            PG8_LDB(B0, 1, 0); PG8_LDB(B1, 1, 1); PG8_SCHED; PG8_LDA(At, 1, 0); PG8_STAGE(PG8_SA(0, 1), a2 + hstep, voffA);
            PG8_WAIT_V(8); PG8_WAIT_L(0); PG8_BAR; PG8_MMA(0, 0, At, B0); PG8_MMA(0, 1, At, B1); PG8_BAR; PG8_SCHED;
            PG8_LDA(At, 1, 1); PG8_STAGE(PG8_SB(1, 0), b3, voffB); PG8_STAGE(PG8_SB(1, 1), b3 + hstep, voffB); PG8_STAGE(PG8_SA(1, 0), a3, voffA);
            PG8_WAIT_V(8); PG8_WAIT_L(0); PG8_BAR; PG8_MMA(1, 0, At, B0); PG8_MMA(1, 1, At, B1); PG8_BAR; PG8_SCHED;
            } else {
            PG8_LDB(B0, 0, 0); PG8_SCHED; PG8_LDA(At, 0, 0); PG8_STAGE(PG8_SA(1, 1), a1 + hstep, voffA);
            PG8_WAIT_L(8); PG8_BAR; PG8_WAIT_L(0); PG8_MMA(0, 0, At, B0); PG8_BAR; PG8_SCHED;
            PG8_LDB(B1, 0, 1); PG8_STAGE(PG8_SB(0, 0), b2, voffB);
            PG8_BAR; PG8_WAIT_L(0); PG8_MMA(0, 1, At, B1); PG8_BAR;
            PG8_LDA(At, 0, 1); PG8_STAGE(PG8_SA(0, 0), a2, voffA);
            PG8_BAR; PG8_WAIT_L(0); PG8_MMA(1, 0, At, B0); PG8_BAR; PG8_SCHED;
            PG8_STAGE(PG8_SB(0, 1), b2 + hstep, voffB);
            PG8_WAIT_V(6); PG8_BAR; PG8_MMA(1, 1, At, B1); PG8_BAR;
            PG8_LDB(B0, 1, 0); PG8_SCHED; PG8_LDA(At, 1, 0); PG8_STAGE(PG8_SA(0, 1), a2 + hstep, voffA);
            PG8_WAIT_L(8); PG8_BAR; PG8_WAIT_L(0); PG8_MMA(0, 0, At, B0); PG8_BAR; PG8_SCHED;
            PG8_LDB(B1, 1, 1); PG8_STAGE(PG8_SB(1, 0), b3, voffB);
            PG8_BAR; PG8_WAIT_L(0); PG8_MMA(0, 1, At, B1); PG8_BAR;
            PG8_LDA(At, 1, 1); PG8_STAGE(PG8_SA(1, 0), a3, voffA);
            PG8_BAR; PG8_WAIT_L(0); PG8_MMA(1, 0, At, B0); PG8_BAR; PG8_SCHED;
            PG8_STAGE(PG8_SB(1, 1), b3 + hstep, voffB);
            PG8_WAIT_V(6); PG8_BAR; PG8_MMA(1, 1, At, B1); PG8_BAR;
            }
        }
        if constexpr (ALIGN_EPI) { if (wr == 0) PG8_BAR; }
        if constexpr (!Epi::AFTER_DRAIN) { E(acc, cur, wr, wc, fr, fq); S.done(cur); }
        if (!has_next) break;
#pragma unroll
        for (int a = 0; a < 2; ++a)
#pragma unroll
            for (int b = 0; b < 2; ++b)
#pragma unroll
                for (int m = 0; m < 4; ++m)
#pragma unroll
                    for (int n = 0; n < 2; ++n) acc[a][b][m][n] = (f32x4){0.f, 0.f, 0.f, 0.f};
        cur = nxt; cA = nA; cB = nB; ++ui;
        if constexpr (ALIGN_EPI) { if (wr == 1) PG8_BAR; }
    }
    PG8_WAIT_V(0);
    if constexpr (!ALIGN_EPI) { if (wr == 0) PG8_BAR; }
    PG8_BAR;
    if constexpr (Epi::AFTER_DRAIN) { E.fused(acc, cur, wr, wc, fr, fq, lds, wid, lane); S.done(cur); }
#undef PG8_SA
#undef PG8_SB
#undef PG8_STAGE
#undef PG8_LDA
#undef PG8_LDB
#undef PG8_MMA
#undef PG8_WAIT_V
#undef PG8_WAIT_L
#undef PG8_BAR
#undef PG8_SCHED
}
}
typedef pg8::pg8_lds_t_ pg8_lds_t;
using pg8::bf16_t; using pg8::bf16x8; using pg8::f32x4; using pg8::u32x4; using pg8::cvt_pk_bf16;
typedef float f32x16 __attribute__((ext_vector_type(16)));
#define MFMA32(a, b, c) __builtin_amdgcn_mfma_f32_32x32x16_bf16((a), (b), (c), 0, 0, 0)
typedef unsigned u32x2_t __attribute__((ext_vector_type(2)));
#define DI __device__ __forceinline__
#define LDS_WAIT() asm volatile("s_waitcnt lgkmcnt(0)" ::: "memory")

constexpr int NTHR = 512;
constexpr int T_LAT = 16384, T_ALL = 18432;
constexpr size_t SZ_MOD = (size_t)4 * 9 * 9216 * 4;
constexpr size_t OFF_BAR = 0;
constexpr size_t SZ_BAR = 16384;
constexpr size_t OFF_MOD = OFF_BAR + SZ_BAR;
constexpr size_t OFF_ROPE_RET = OFF_MOD + SZ_MOD;
constexpr size_t OFF_ROPE_AX = OFF_ROPE_RET + (size_t)2048 * 64 * 8;
constexpr size_t OFF_X   = OFF_ROPE_AX + (size_t)64 * 16 * 8;
constexpr size_t OFF_HY  = OFF_X + (size_t)T_ALL * 1024 * 4;
constexpr size_t OFF_WFI = OFF_HY + (size_t)T_ALL * 2048 * 2;
constexpr size_t OFF_WFO = OFF_WFI + (size_t)5632 * 1024 * 2;
constexpr size_t OFF_WMI = OFF_WFO + (size_t)1024 * 2816 * 2;
constexpr size_t OFF_WMO = OFF_WMI + (size_t)6144 * 1024 * 2;
constexpr size_t OFF_WFI2 = OFF_WMO + (size_t)1024 * 2048 * 2;
constexpr size_t OFF_WFO2 = OFF_WFI2 + (size_t)5632 * 1024 * 2;
constexpr size_t OFF_WFOS  = OFF_WFO2 + (size_t)1024 * 2816 * 2;
constexpr size_t OFF_WFOS2 = OFF_WFOS + (size_t)2 * 1024 * 1408 * 2;
constexpr size_t OFF_BIG = OFF_WFOS2 + (size_t)2 * 1024 * 1408 * 2;
constexpr size_t OFF_HID = OFF_BIG;
constexpr size_t OFF_HIDC = OFF_BIG + (size_t)T_ALL * 2816 * 2;
constexpr size_t OFF_PART = OFF_HIDC + (size_t)2 * 2048 * 1408 * 2;
constexpr size_t OFF_ABP = OFF_BIG;
constexpr size_t OFF_QN  = OFF_ABP + (size_t)T_ALL * 3840 * 2;
constexpr size_t OFF_KN  = OFF_QN + (size_t)T_ALL * 512 * 4;
constexpr size_t OFF_VN  = OFF_KN + (size_t)T_ALL * 512 * 4;
constexpr size_t OFF_LA  = OFF_VN + (size_t)T_ALL * 512 * 4;
constexpr size_t OFF_BE  = OFF_LA + (size_t)T_ALL * 8 * 4;
constexpr size_t OFF_ODN = OFF_QN;
constexpr size_t OFF_QD  = OFF_BE + (size_t)T_ALL * 8 * 4;
constexpr size_t OFF_KD  = OFF_QD + (size_t)32 * 2304 * 128 * 2;
constexpr size_t OFF_VT  = OFF_KD + (size_t)32 * 2304 * 128 * 2;
constexpr size_t OFF_DW  = OFF_VT + (size_t)32 * 2304 * 128 * 2;
constexpr size_t OFF_DQE = OFF_DW + (size_t)2 * 1152 * 64 * 128 * 2;
constexpr size_t OFF_DKT = OFF_DQE + (size_t)2 * 1152 * 64 * 128 * 2;
constexpr size_t OFF_DQK = OFF_DKT + (size_t)2 * 1152 * 128 * 64 * 2;
constexpr size_t OFF_DUT = OFF_DQK + (size_t)2 * 1152 * 64 * 64 * 2;
constexpr size_t OFF_DEG = OFF_DUT + (size_t)2 * 1152 * 128 * 64 * 4;
constexpr size_t END_AB  = OFF_DEG + (size_t)2 * 1152 * 4 + 256;
constexpr size_t OFF_RP  = OFF_BIG;
constexpr size_t RP_STRIDE = (size_t)T_ALL * 2048;
constexpr size_t OFF_QR  = OFF_RP + 3 * RP_STRIDE * 2;
constexpr size_t OFF_KR  = OFF_QR + (size_t)T_ALL * 1024 * 2;
constexpr size_t OFF_KDT = OFF_KR + (size_t)T_ALL * 1024 * 2;
constexpr size_t OFF_VTR = OFF_KDT + (size_t)2 * 288 * 8 * 128 * 64 * 2;
constexpr size_t OFF_OR  = OFF_RP;
constexpr size_t END_RET = OFF_VTR + (size_t)288 * 8 * 256 * 64 * 2;
constexpr size_t OFF_WMOS_AB = OFF_HY + (size_t)T_ALL * 1024 * 2;
constexpr size_t OFF_WMOS_RET = END_RET;
constexpr size_t WS_NEED = (END_RET + (size_t)1024 * 2048 * 2) > END_AB ? (END_RET + (size_t)1024 * 2048 * 2) : END_AB;

struct Prm {
    const float *x, *c, *ctx, *c_ctx, *ada_w, *ada_b, *norm_w, *final_norm_w, *ffn_w_in, *ffn_w_out, *ab_w_in, *ab_conv_w, *dn_A_log, *dn_dt_bias,
        *dn_norm_w, *diff_lambda, *diff_subln_w, *ab_w_out, *ret_w_in, *ret_decay_logit, *ret_w_out;
    float* out; unsigned char* ws;
};

typedef const Prm __attribute__((address_space(4)))* PrmC;
DI PrmC get_prm() { auto k = __builtin_amdgcn_kernarg_segment_ptr(); asm volatile("" : "+s"(k)); return (PrmC)k; }
DI float bf2f(unsigned v) { return __uint_as_float(v << 16); }
DI unsigned f2bf(float f) { unsigned u = __float_as_uint(f); return (u + 0x7fffu + ((u >> 16) & 1u)) >> 16; }
DI unsigned pk2(float lo, float hi) { return f2bf(lo) | (f2bf(hi) << 16); }
DI void unpack8(const uint4 v, float* f) {
    f[0] = __uint_as_float(v.x << 16); f[1] = __uint_as_float(v.x & 0xffff0000u); f[2] = __uint_as_float(v.y << 16); f[3] = __uint_as_float(v.y & 0xffff0000u);
    f[4] = __uint_as_float(v.z << 16); f[5] = __uint_as_float(v.z & 0xffff0000u); f[6] = __uint_as_float(v.w << 16); f[7] = __uint_as_float(v.w & 0xffff0000u);
}
DI uint4 pack8(const float* f) { uint4 o; o.x = pk2(f[0], f[1]); o.y = pk2(f[2], f[3]); o.z = pk2(f[4], f[5]); o.w = pk2(f[6], f[7]); return o; }
template <int CTRL> DI float dpp_f(float v) { return __int_as_float(__builtin_amdgcn_update_dpp(0, __float_as_int(v), CTRL, 0xF, 0xF, true)); }
DI float sum4(float v)  { v += dpp_f<0xB1>(v); v += dpp_f<0x4E>(v); return v; }
DI float sum8(float v)  { v = sum4(v); v += dpp_f<0x141>(v); return v; }
DI float sum16(float v) { v = sum8(v); v += dpp_f<0x140>(v); return v; }
DI float wave_sum(float v) {
#pragma unroll
    for (int o = 1; o < 64; o <<= 1) v += __shfl_xor(v, o);
    return v;
}
DI float silu_f(float g) { return g / (1.0f + __expf(-g)); }

DI void phase_mod(PrmC p, unsigned char* smem) {
    float* s_sh = (float*)smem;
    unsigned redb_ = 9 * 1024 * 4; asm volatile("" : "+v"(redb_));
    __attribute__((address_space(3))) float* red = (__attribute__((address_space(3))) float*)(uintptr_t)redb_;
    float* MOD = (float*)(p->ws + OFF_MOD);
    const int tid = opaque_tid(), lane = tid & 63, ks = tid >> 6;
    { float2* RT = (float2*)(p->ws + OFF_ROPE_RET); float2* AX = (float2*)(p->ws + OFF_ROPE_AX);
      for (int i = bid() * NTHR + tid; i < 2048 * 64; i += gdim() * NTHR) { const float ang = (float)(i >> 6) * exp2f(-(float)(i & 63) * (13.287712379549449f / 63.0f)); RT[i] = make_float2(cosf(ang), sinf(ang)); }
      for (int i = bid() * NTHR + tid; i < 64 * 16; i += gdim() * NTHR) { const float ang = (float)(i >> 4) * exp2f(-(float)(i & 15) * (13.287712379549449f / 16.0f)); AX[i] = make_float2(cosf(ang), sinf(ang)); } }
    for (int i = tid; i < 9 * 1024; i += NTHR) { const int rr = i >> 10, kk = i & 1023; const float cv = rr < 8 ? p->c[rr * 1024 + kk] : p->c_ctx[kk]; s_sh[i] = silu_f(cv); }
    __syncthreads();
    for (int it = bid(); it < 144; it += gdim()) {
        const int l = it / 36, cb = it % 36, col = cb * 256 + lane * 4;
        const float* w = p->ada_w + ((size_t)l * 1024 + ks * 128) * 9216 + col;
        float acc[9][4];
#pragma unroll
        for (int a = 0; a < 9; ++a) { acc[a][0] = 0.f; acc[a][1] = 0.f; acc[a][2] = 0.f; acc[a][3] = 0.f; }
#pragma unroll 4
        for (int k = 0; k < 128; ++k) { const float4 wv = *(const float4*)(w + (size_t)k * 9216);
#pragma unroll
            for (int a = 0; a < 9; ++a) { const float sv = s_sh[a * 1024 + ks * 128 + k]; acc[a][0] += sv * wv.x; acc[a][1] += sv * wv.y; acc[a][2] += sv * wv.z; acc[a][3] += sv * wv.w; } }
#pragma unroll
        for (int a = 0; a < 9; ++a) *(float4*)(red + (ks * 9 + a) * 256 + lane * 4) = make_float4(acc[a][0], acc[a][1], acc[a][2], acc[a][3]);
        __syncthreads();
        for (int o = tid; o < 9 * 256; o += NTHR) { const int a = o >> 8, c = o & 255; float v = p->ada_b[l * 9216 + cb * 256 + c];
#pragma unroll
            for (int q = 0; q < 8; ++q) v += red[(q * 9 + a) * 256 + c];
            MOD[((size_t)l * 9 + a) * 9216 + cb * 256 + c] = v; }
        __syncthreads();
    }
}

template <int MODE> DI int dest_row(int n) {
    if (MODE == 0 || MODE == 3) return n;
    if (MODE == 1) { const int bj = n >= 2816 ? 1 : 0, r = n - bj * 2816; return 256 * (r >> 7) + 128 * bj + (r & 127); }
    return n < 2048 ? n : (n < 2064 ? 3584 + (n - 2048) : n - 16);
}
template <int MODE> DI void convert_weights(const float* W, int K, int N, bf16_t* WT, float* scr, int gw, int NGW, int& rot, int khalf = 1408, bf16_t* WT2 = nullptr) {
    const int lane = opaque_tid() & 63;
    const int nblk = (N + 63) >> 6, nitems = (K >> 6) * nblk;
    int first = gw - rot; if (first < 0) first += NGW;
    for (int item = first; item < nitems; item += NGW) {
        const int kb = item / nblk, nb = item - kb * nblk, k0 = kb << 6, n0 = nb << 6;
        const int nl = (lane & 15) * 4, kr = lane >> 4;
        const bool ok = n0 + nl < N;
        float4 v[16];
#pragma unroll
        for (int i = 0; i < 16; ++i) v[i] = ok ? *(const float4*)(W + (size_t)(k0 + 4 * i + kr) * N + n0 + nl) : make_float4(0.f, 0.f, 0.f, 0.f);
#pragma unroll
        for (int i = 0; i < 16; ++i) *(float4*)(scr + (4 * i + kr) * 68 + nl) = v[i];
        LDS_WAIT();
        const int nn = n0 + lane;
        if (nn < N) {
            bf16_t* dst = MODE == 3 ? WT + ((size_t)(k0 / khalf) * 1024 + nn) * khalf + (k0 % khalf) : WT + (size_t)dest_row<MODE>(nn) * K + k0;
            bf16_t* dst2 = WT2 ? WT2 + ((size_t)(k0 / khalf) * 1024 + nn) * khalf + (k0 % khalf) : nullptr;
#pragma unroll
            for (int kg = 0; kg < 8; ++kg) { const float* t = scr + (8 * kg) * 68 + lane;
                uint4 o; o.x = pk2(t[0 * 68], t[1 * 68]); o.y = pk2(t[2 * 68], t[3 * 68]); o.z = pk2(t[4 * 68], t[5 * 68]); o.w = pk2(t[6 * 68], t[7 * 68]);
                *(uint4*)(dst + 8 * kg) = o; if (WT2) *(uint4*)(dst2 + 8 * kg) = o; }
        }
        LDS_WAIT();
    }
    rot = (rot + nitems) % NGW;
}

DI void norm_rows(PrmC p, const float* xlat, const float* xctx, int l, int sub, int nrows, int gw, int NGW, int& rot, const float* fixgate, float fixs) {
    const int lane = opaque_tid() & 63;
    const float* MOD = (const float*)(p->ws + OFF_MOD);
    bf16_t* H = (bf16_t*)(p->ws + OFF_HY);
    const float* nw = p->norm_w + ((size_t)l * 3 + sub) * 1024;
    const float* PART = (const float*)(p->ws + OFF_PART); float* X = (float*)(p->ws + OFF_X);
    int first = gw - rot; if (first < 0) first += NGW;
    for (int row0 = first; row0 < nrows; row0 += 4 * NGW) {
        float4 v[4][4]; float ss[4];
#pragma unroll
        for (int rr = 0; rr < 4; ++rr) { const int row = row0 + rr * NGW < nrows ? row0 + rr * NGW : row0;
            const float* xr = row < T_LAT ? xlat + (size_t)row * 1024 : xctx + (size_t)(row - T_LAT) * 1024;
#pragma unroll
            for (int j = 0; j < 4; ++j) v[rr][j] = *(const float4*)(xr + j * 256 + lane * 4); }
        if (fixgate) {
#pragma unroll
            for (int rr = 0; rr < 4; ++rr) { const int row = row0 + rr * NGW;
                if (row < nrows && row >= T_LAT) { const float* p0 = PART + (size_t)(row - T_LAT) * 1024; const float* p1 = p0 + (size_t)2048 * 1024;
#pragma unroll
                    for (int j = 0; j < 4; ++j) { const int c = j * 256 + lane * 4; const float4 g = *(const float4*)(fixgate + c), a = *(const float4*)(p0 + c), b2 = *(const float4*)(p1 + c);
                        v[rr][j].x += fixs * g.x * (a.x + b2.x); v[rr][j].y += fixs * g.y * (a.y + b2.y); v[rr][j].z += fixs * g.z * (a.z + b2.z); v[rr][j].w += fixs * g.w * (a.w + b2.w);
                        *(float4*)(X + (size_t)row * 1024 + c) = v[rr][j]; } } }
        }
#pragma unroll
        for (int rr = 0; rr < 4; ++rr) { float s = 0.f;
#pragma unroll
            for (int j = 0; j < 4; ++j) s += v[rr][j].x * v[rr][j].x + v[rr][j].y * v[rr][j].y + v[rr][j].z * v[rr][j].z + v[rr][j].w * v[rr][j].w;
            ss[rr] = s; }
#pragma unroll
        for (int o = 1; o < 64; o <<= 1) {
#pragma unroll
            for (int rr = 0; rr < 4; ++rr) ss[rr] += __shfl_xor(ss[rr], o); }
#pragma unroll
        for (int rr = 0; rr < 4; ++rr) { const int row = row0 + rr * NGW;
            if (row < nrows) {
                const float rs = rsqrtf(ss[rr] * (1.0f / 1024.0f) + 1e-6f);
                const float* md = MOD + (((size_t)l * 9 + (row < T_LAT ? (row >> 11) : 8)) * 9 + 3 * sub) * 1024;
#pragma unroll
                for (int j = 0; j < 4; ++j) { const int c = j * 256 + lane * 4;
                    const float4 w = *(const float4*)(nw + c), sh = *(const float4*)(md + c), sc = *(const float4*)(md + 1024 + c);
                    uint2 o; o.x = pk2(v[rr][j].x * rs * w.x * (1.f + sc.x) + sh.x, v[rr][j].y * rs * w.y * (1.f + sc.y) + sh.y); o.y = pk2(v[rr][j].z * rs * w.z * (1.f + sc.z) + sh.z, v[rr][j].w * rs * w.w * (1.f + sc.w) + sh.w);
                    *(uint2*)(H + (size_t)row * 1024 + c) = o; } } }
    }
    rot = (rot + nrows) % NGW;
}

DI void phase_ab_prep(PrmC p, int ai, unsigned char* smem) {
    const bf16_t* P = (const bf16_t*)(p->ws + OFF_ABP);
    bf16_t* QN = (bf16_t*)(p->ws + OFF_QN); bf16_t* KN = (bf16_t*)(p->ws + OFF_KN); float* VN = (float*)(p->ws + OFF_VN);
    float* LA = (float*)(p->ws + OFF_LA); float* BE = (float*)(p->ws + OFF_BE);
    bf16_t* QD = (bf16_t*)(p->ws + OFF_QD); bf16_t* KD = (bf16_t*)(p->ws + OFF_KD); bf16_t* VT = (bf16_t*)(p->ws + OFF_VT);
    const float* cw = p->ab_conv_w + (size_t)ai * 3 * 1536;
    bf16_t* vt_l = (bf16_t*)smem;
    const int tid = opaque_tid(), lane = tid & 63, wave = tid >> 6;
    for (int item = bid(); item < T_ALL / 16; item += gdim()) {
        const int r0 = item * 16; const bool lat = r0 < T_LAT;
        const int b = lat ? (r0 >> 11) : ((r0 - T_LAT) >> 8), t0 = lat ? (r0 & 2047) : ((r0 - T_LAT) & 255), Ls = lat ? 2048 : 256, key0 = lat ? 256 + t0 : t0;
        __syncthreads();
        for (int idx = tid; idx < 1024; idx += NTHR) { const int rr = idx >> 6, seg = idx & 63;
            *(uint4*)(vt_l + rr * 520 + seg * 8) = *(const uint4*)(P + (size_t)(r0 + rr) * 3840 + 3072 + seg * 8); }
        __syncthreads();
        { const int hh = tid >> 7, dv = tid & 127; unsigned w[8];
#pragma unroll
            for (int k = 0; k < 8; ++k) w[k] = (unsigned)vt_l[(2 * k) * 520 + tid] | ((unsigned)vt_l[(2 * k + 1) * 520 + tid] << 16);
            bf16_t* dst = VT + ((size_t)((b * 4 + hh) * 128 + dv)) * 2304 + key0;
            *(uint4*)dst = make_uint4(w[0], w[1], w[2], w[3]); *(uint4*)(dst + 8) = make_uint4(w[4], w[5], w[6], w[7]); }
#pragma unroll
        for (int tt = 0; tt < 2; ++tt) {
            const int row = r0 + 2 * wave + tt, ti = t0 + 2 * wave + tt;
            const bf16_t* pr = P + (size_t)row * 3840;
            float res[3][8];
#pragma unroll
            for (int sec = 0; sec < 3; ++sec) {
                const int ch = sec * 512 + lane * 8;
                float acc[8];
#pragma unroll
                for (int e = 0; e < 8; ++e) acc[e] = 0.f;
#pragma unroll
                for (int tap = 0; tap < 3; ++tap) {
                    const int tn = ti + tap - 1;
                    if (tn >= 0 && tn < Ls) {
                        float u[8]; unpack8(*(const uint4*)(pr + (ptrdiff_t)(tap - 1) * 3840 + ch), u);
                        const float4 w0 = *(const float4*)(cw + tap * 1536 + ch), w1 = *(const float4*)(cw + tap * 1536 + ch + 4);
                        acc[0] += w0.x * u[0]; acc[1] += w0.y * u[1]; acc[2] += w0.z * u[2]; acc[3] += w0.w * u[3];
                        acc[4] += w1.x * u[4]; acc[5] += w1.y * u[5]; acc[6] += w1.z * u[6]; acc[7] += w1.w * u[7];
                    }
                }
#pragma unroll
                for (int e = 0; e < 8; ++e) res[sec][e] = silu_f(acc[e]);
            }
            { float sq = 0.f, sk = 0.f;
#pragma unroll
              for (int e = 0; e < 8; ++e) { sq += res[0][e] * res[0][e]; sk += res[1][e] * res[1][e]; }
              sq = sum16(sq); sk = sum16(sk);
              const float rq = rsqrtf(sq + 1e-6f) * 0.08838834764831845f, rk = rsqrtf(sk + 1e-6f);
              float* vo = VN + (size_t)row * 512 + lane * 8;
              float qs8[8], ks8[8];
#pragma unroll
              for (int e = 0; e < 8; ++e) { qs8[e] = res[0][e] * rq; ks8[e] = res[1][e] * rk; }
              *(uint4*)(QN + (size_t)row * 512 + lane * 8) = pack8(qs8); *(uint4*)(KN + (size_t)row * 512 + lane * 8) = pack8(ks8);
              *(float4*)vo = make_float4(res[2][0], res[2][1], res[2][2], res[2][3]); *(float4*)(vo + 4) = make_float4(res[2][4], res[2][5], res[2][6], res[2][7]); }
            if (lane < 8) { const float a = bf2f(pr[3584 + lane]) + p->dn_dt_bias[ai * 8 + lane];
                const float sp = a > 20.f ? a : log1pf(__expf(a));
                LA[(size_t)row * 8 + lane] = -__expf(p->dn_A_log[ai * 8 + lane]) * sp; }
            else if (lane < 16) { const float bb = bf2f(pr[3592 + lane - 8]); BE[(size_t)row * 8 + lane - 8] = 1.0f / (1.0f + __expf(-bb)); }
            { float q[8], k[8]; unpack8(*(const uint4*)(pr + 2048 + lane * 8), q); unpack8(*(const uint4*)(pr + 2560 + lane * 8), k);
              const int hh = lane >> 4, cc = (lane & 15) * 8, d0 = cc & 63;
              if (lat) {
                  const int o = d0 & 31; const int ipos = (d0 & 32) ? (ti & 63) : (ti >> 6); const bool firsth = o < 16;
                  const float2* ax = (const float2*)(p->ws + OFF_ROPE_AX) + ipos * 16 + (o & 15);
#pragma unroll
                  for (int e = 0; e < 8; ++e) {
                      const float qp = __shfl_xor(q[e], 2), kp = __shfl_xor(k[e], 2);
                      const float2 cs2 = ax[e];
                      q[e] = q[e] * cs2.x + (firsth ? -qp : qp) * cs2.y; k[e] = k[e] * cs2.x + (firsth ? -kp : kp) * cs2.y;
                  }
              }
              const float qs = 0.125f * 1.4426950408889634f;
#pragma unroll
              for (int e = 0; e < 8; ++e) q[e] *= qs;
              const size_t off = ((size_t)(b * 4 + hh) * 2304 + key0 + 2 * wave + tt) * 128 + cc;
              *(uint4*)(QD + off) = pack8(q); *(uint4*)(KD + off) = pack8(k); }
        }
    }
}

DI int xcd_group_item(int blk, int G) { if (G != 256) return blk; const int x = blk & 7, k = blk >> 3; return ((x + 8 * (k >> 2)) << 2) + (k & 3); }
DI int seq_row(int b, int dir, int pos) {
    if (pos < 256) return T_LAT + b * 256 + (dir ? 255 - pos : pos);
    const int i = pos - 256; return b * 2048 + (dir ? 2047 - i : i);
}
typedef float __attribute__((address_space(3)))* lf_t;
typedef float __attribute__((address_space(3)))* lf_t;
template <int D> DI void dn_rhs(float (&x)[64], const float* VN, lf_t Kl, lf_t Gn, lf_t Bn, int row0, int h, int t) {
            asm volatile("" : "+v"(t));
            const lf_t Gd = Gn + D * 64, Bd = Bn + D * 64;
            if (t < 128) {
                unsigned voff = (unsigned)(((row0 + (D ? 63 : 0)) * 512 + h * 128 + t) * 4);
#pragma unroll
                for (int pi = 0; pi < 64; ++pi) { const int n = D ? 63 - pi : pi; x[pi] = *(const float*)((const char*)VN + voff) * Bd[n]; voff += D ? -2048 : 2048; asm volatile("" : "+v"(voff)); }
            } else {
#pragma unroll
                for (int pi = 0; pi < 64; ++pi) { const int n = D ? 63 - pi : pi; x[pi] = Kl[n * 132 + (t - 128)] * Bd[n] * __expf(Gd[n]); }
            }
}
DI void dn_solve_core(float (&x)[64], lf_t Ad) {
    float4 cur[16], nxt[16];
    cur[0] = *(const float4*)(Ad + 68);
#pragma unroll
    for (int pi = 1; pi < 64; ++pi) {
        if (pi + 1 < 64) {
#pragma unroll
            for (int g4 = 0; g4 < (pi + 4) / 4; ++g4) nxt[g4] = *(const float4*)(Ad + (pi + 1) * 68 + 4 * g4);
        }
        float a = x[pi], a2 = 0.f;
#pragma unroll
        for (int g4 = 0; g4 < (pi + 3) / 4; ++g4) { const float4 av = cur[g4];
            if (4 * g4 + 0 < pi) a -= av.x * x[4 * g4 + 0];
            if (4 * g4 + 1 < pi) a2 -= av.y * x[4 * g4 + 1];
            if (4 * g4 + 2 < pi) a -= av.z * x[4 * g4 + 2];
            if (4 * g4 + 3 < pi) a2 -= av.w * x[4 * g4 + 3]; }
        x[pi] = a + a2;
        asm volatile("" ::: "memory");
#pragma unroll
        for (int g4 = 0; g4 < (pi + 4) / 4; ++g4) cur[g4] = nxt[g4];
    }
}
template <int D> DI void dn_out(float (&x)[64], lf_t Kl, lf_t Ql, lf_t Gn, bf16_t* DW, bf16_t* DQE, bf16_t* DKT, bf16_t* DUT, float* DEG, int item, int t) {
            asm volatile("" : "+v"(t));
            const lf_t Gd = Gn + D * 64;
            if (t < 128) { bf16_t* uo = DUT + (((size_t)D * 1152 + item) * 128 + t) * 64;
#pragma unroll
                for (int g8 = 0; g8 < 8; ++g8) *(uint4*)(uo + 8 * g8) = pack8(x + 8 * g8);
            } else { bf16_t* wbase = DW + (((size_t)D * 1152 + item) * 64) * 128; unsigned woff = (unsigned)((t - 128) * 2);
#pragma unroll
                for (int pi = 0; pi < 64; ++pi) { *(bf16_t*)((char*)wbase + woff) = (bf16_t)f2bf(x[pi]); woff += 256; asm volatile("" : "+v"(woff)); } }
            const float glast = Gd[D ? 0 : 63];
#pragma unroll
            for (int i = 0; i < 4; ++i) { const int idx = t + 256 * i, pi = idx >> 4, seg = idx & 15, n = D ? 63 - pi : pi; const float e = __expf(Gd[n]);
                const float4 a0 = *(const float4*)(Ql + n * 132 + seg * 8), a1 = *(const float4*)(Ql + n * 132 + seg * 8 + 4);
                uint4 o; o.x = pk2(a0.x * e, a0.y * e); o.y = pk2(a0.z * e, a0.w * e); o.z = pk2(a1.x * e, a1.y * e); o.w = pk2(a1.z * e, a1.w * e);
                *(uint4*)(DQE + (((size_t)D * 1152 + item) * 64 + pi) * 128 + seg * 8) = o; }
#pragma unroll
            for (int i = 0; i < 4; ++i) { const int idx = t + 256 * i, dk = idx & 127, pg = idx >> 7; float v[8];
#pragma unroll
                for (int e = 0; e < 8; ++e) { const int pi = 8 * pg + e, n = D ? 63 - pi : pi; v[e] = Kl[n * 132 + dk] * __expf(glast - Gd[n]); }
                *(uint4*)(DKT + (((size_t)D * 1152 + item) * 128 + dk) * 64 + 8 * pg) = pack8(v); }
            if (t == 0) DEG[D * 1152 + item] = __expf(glast);
}

DI void phase_dn_chunkprep(PrmC p, unsigned char* smem, int vb, int nvb) {
    const bf16_t* QN = (const bf16_t*)(p->ws + OFF_QN); const bf16_t* KN = (const bf16_t*)(p->ws + OFF_KN); const float* VN = (const float*)(p->ws + OFF_VN);
    const float* LA = (const float*)(p->ws + OFF_LA); const float* BE = (const float*)(p->ws + OFF_BE);
    bf16_t* DW = (bf16_t*)(p->ws + OFF_DW); bf16_t* DQE = (bf16_t*)(p->ws + OFF_DQE); bf16_t* DKT = (bf16_t*)(p->ws + OFF_DKT); bf16_t* DQK = (bf16_t*)(p->ws + OFF_DQK);
    bf16_t* DUT = (bf16_t*)(p->ws + OFF_DUT); float* DEG = (float*)(p->ws + OFF_DEG);
    typedef float __attribute__((address_space(3)))* lf;
    unsigned bK_ = 0u, bQ_ = 64 * 132 * 4, bA_ = 2 * 64 * 132 * 4, bG_ = 2 * 64 * 132 * 4 + 2 * 64 * 68 * 4, bB_ = 2 * 64 * 132 * 4 + 2 * 64 * 68 * 4 + 1024;
    asm volatile("" : "+v"(bK_), "+v"(bQ_), "+v"(bA_), "+v"(bG_), "+v"(bB_));
    typedef __attribute__((address_space(3))) unsigned char* lb;
    const lb Kb = (lb)(uintptr_t)bB_, Qb = Kb + 64 * 272;
    const lf Kl = (lf)(uintptr_t)bK_, Ql = (lf)(uintptr_t)bQ_, Al = (lf)(uintptr_t)bA_, Gn = (lf)(uintptr_t)bG_, Bn = Gn + 128;
    (void)smem;
    const int tid = opaque_tid(), d = __builtin_amdgcn_readfirstlane(tid >> 8), t = tid & 255;
    for (int item = vb < 0 ? 1152 : vb; item < 1152; item += nvb) {
        const int cidx = item % 36, bh = item / 36, h = bh & 3, b = bh >> 2;
        const int row0 = cidx < 4 ? T_LAT + b * 256 + cidx * 64 : b * 2048 + (cidx - 4) * 64;
        __syncthreads();
#pragma unroll
        for (int i = 0; i < 2; ++i) { const int idx = tid + i * NTHR, n = idx >> 4, seg = idx & 15; float kf[8], qf8[8];
            const uint4 kraw = *(const uint4*)(KN + (size_t)(row0 + n) * 512 + h * 128 + seg * 8), qraw = *(const uint4*)(QN + (size_t)(row0 + n) * 512 + h * 128 + seg * 8);
            unpack8(kraw, kf); unpack8(qraw, qf8);
            *(__attribute__((address_space(3))) u32x4*)(Kb + n * 272 + seg * 16) = (u32x4){kraw.x, kraw.y, kraw.z, kraw.w}; *(__attribute__((address_space(3))) u32x4*)(Qb + n * 272 + seg * 16) = (u32x4){qraw.x, qraw.y, qraw.z, qraw.w};
            *(float4*)(Kl + n * 132 + seg * 8) = make_float4(kf[0], kf[1], kf[2], kf[3]); *(float4*)(Kl + n * 132 + seg * 8 + 4) = make_float4(kf[4], kf[5], kf[6], kf[7]);
            *(float4*)(Ql + n * 132 + seg * 8) = make_float4(qf8[0], qf8[1], qf8[2], qf8[3]); *(float4*)(Ql + n * 132 + seg * 8 + 4) = make_float4(qf8[4], qf8[5], qf8[6], qf8[7]); }
        if (t < 64) {
            const int n = d ? 63 - t : t;
            float x = LA[(size_t)(row0 + n) * 8 + d * 4 + h];
#pragma unroll
            for (int o = 1; o < 64; o <<= 1) { const float y = __shfl_up(x, o); if (t >= o) x += y; }
            Gn[d * 64 + n] = x; Bn[d * 64 + n] = BE[(size_t)(row0 + n) * 8 + d * 4 + h];
        }
        __syncthreads();
        {
            int tb = tid; asm volatile("" : "+v"(tb));
            const int lane = tb & 63, wv = tb >> 6, r = lane & 31, hh = lane >> 5, sel = wv >> 2, it = (wv >> 1) & 1, jt = wv & 1;
            const lb Ab = sel ? Qb : Kb;
            f32x16 acc;
#pragma unroll
            for (int i = 0; i < 16; ++i) acc[i] = 0.f;
#pragma unroll
            for (int ks = 0; ks < 8; ++ks) { const bf16x8 a = *(const __attribute__((address_space(3))) bf16x8*)(Ab + (32 * it + r) * 272 + (16 * ks + 8 * hh) * 2);
                const bf16x8 bb = *(const __attribute__((address_space(3))) bf16x8*)(Kb + (32 * jt + r) * 272 + (16 * ks + 8 * hh) * 2); acc = MFMA32(a, bb, acc); }
            const int nj = 32 * jt + r; const float g0j = Gn[nj], g1j = Gn[64 + nj];
            if (sel == 0) {
#pragma unroll
                for (int i = 0; i < 16; ++i) { const int ni = 32 * it + (i & 3) + 8 * (i >> 2) + 4 * hh;
                    if (ni > nj) Al[ni * 68 + nj] = Bn[ni] * acc[i] * __expf(Gn[ni] - g0j);
                    else if (ni < nj) Al[64 * 68 + (63 - ni) * 68 + (63 - nj)] = Bn[64 + ni] * acc[i] * __expf(Gn[64 + ni] - g1j); }
            } else {
                bf16_t* q0 = DQK + ((size_t)item * 64) * 64; bf16_t* q1 = DQK + ((size_t)(1152 + item) * 64) * 64;
#pragma unroll
                for (int i = 0; i < 16; ++i) { const int ni = 32 * it + (i & 3) + 8 * (i >> 2) + 4 * hh;
                    const float v0 = ni >= nj ? acc[i] * __expf(Gn[ni] - g0j) : 0.f, v1 = ni <= nj ? acc[i] * __expf(Gn[64 + ni] - g1j) : 0.f;
                    q0[ni * 64 + nj] = (bf16_t)f2bf(v0); q1[(63 - ni) * 64 + (63 - nj)] = (bf16_t)f2bf(v1); }
            }
        }
        __syncthreads();
        { float x[64];
          if (d == 0) dn_rhs<0>(x, VN, Kl, Gn, Bn, row0, h, t); else dn_rhs<1>(x, VN, Kl, Gn, Bn, row0, h, t);
          dn_solve_core(x, Al + d * 64 * 68);
          if (d == 0) dn_out<0>(x, Kl, Ql, Gn, DW, DQE, DKT, DUT, DEG, item, t); else dn_out<1>(x, Kl, Ql, Gn, DW, DQE, DKT, DUT, DEG, item, t); }
    }
}

#define MFMA16(a, b, c) __builtin_amdgcn_mfma_f32_16x16x32_bf16((a), (b), (c), 0, 0, 0)
constexpr int DS_PITCH = 272, DV_PITCH = 144, D_ST = 0, D_VN = 2 * 32 * DS_PITCH, D_EG = D_VN + 32 * DV_PITCH, D_OB = D_EG + 256;
DI void phase_dn_chunkrec(PrmC p, unsigned char* smem) {
    const bf16_t* DW = (const bf16_t*)(p->ws + OFF_DW); const bf16_t* DQE = (const bf16_t*)(p->ws + OFF_DQE); const bf16_t* DKT = (const bf16_t*)(p->ws + OFF_DKT); const bf16_t* DQK = (const bf16_t*)(p->ws + OFF_DQK);
    const bf16_t* DUT = (const bf16_t*)(p->ws + OFF_DUT); const float* DEG = (const float*)(p->ws + OFF_DEG);
    bf16_t* ODN = (bf16_t*)(p->ws + OFF_ODN);
    const int tid = opaque_tid(), lane = tid & 63, wave = tid >> 6, r16 = lane & 15, q4 = lane >> 4, rt = wave >> 1, ct = wave & 1;
    for (int item0 = bid(); item0 < 256; item0 += gdim()) {
        const int item = xcd_group_item(item0, gdim());
        const int sl = item & 3, dir = (item >> 2) & 1, h = (item >> 3) & 3, b = item >> 5, bh = b * 4 + h;
        f32x4 Sacc[2];
        Sacc[0] = (f32x4){0.f, 0.f, 0.f, 0.f}; Sacc[1] = Sacc[0];
        __syncthreads();
        for (int i = tid; i < 32 * DS_PITCH / 16; i += NTHR) *(uint4*)(smem + D_ST + i * 16) = make_uint4(0, 0, 0, 0);
        uint4 wf0, wf1, wf2, wf3, qf0, qf1, qf2, qf3, qk0, qk1, kd00, kd01, kd10, kd11; uint2 uf;
        uint4 nwf0, nwf1, nwf2, nwf3, nqf0, nqf1, nqf2, nqf3, nqk0, nqk1, nkd00, nkd01, nkd10, nkd11; uint2 nuf;
#define DC_CIDX(ch) ((ch) < 4 ? (dir ? 3 - (ch) : (ch)) : 4 + (dir ? 35 - (ch) : (ch) - 4))
#define DC_LOAD(ch, P_) do { const size_t ci_ = (size_t)dir * 1152 + bh * 36 + DC_CIDX(ch); \
            const bf16_t* w_ = DW + (ci_ * 64 + 16 * rt + r16) * 128 + 8 * q4; const bf16_t* e_ = DQE + (ci_ * 64 + 16 * rt + r16) * 128 + 8 * q4; \
            P_##wf0 = *(const uint4*)(w_); P_##wf1 = *(const uint4*)(w_ + 32); P_##wf2 = *(const uint4*)(w_ + 64); P_##wf3 = *(const uint4*)(w_ + 96); \
            P_##qf0 = *(const uint4*)(e_); P_##qf1 = *(const uint4*)(e_ + 32); P_##qf2 = *(const uint4*)(e_ + 64); P_##qf3 = *(const uint4*)(e_ + 96); \
            const bf16_t* k_ = DQK + (ci_ * 64 + 16 * rt + r16) * 64 + 8 * q4; P_##qk0 = *(const uint4*)(k_); P_##qk1 = *(const uint4*)(k_ + 32); \
            const bf16_t* t_ = DKT + (ci_ * 128 + 32 * rt + r16) * 64 + 8 * q4; P_##kd00 = *(const uint4*)(t_); P_##kd01 = *(const uint4*)(t_ + 32); P_##kd10 = *(const uint4*)(t_ + 16 * 64); P_##kd11 = *(const uint4*)(t_ + 16 * 64 + 32); \
            P_##uf = *(const uint2*)(DUT + (ci_ * 128 + sl * 32 + 16 * ct + r16) * 64 + 16 * rt + 4 * q4); } while (0)
        if (tid < 36) ((float*)(smem + D_EG))[tid] = DEG[(size_t)dir * 1152 + bh * 36 + DC_CIDX(tid)];
        DC_LOAD(0, );
        __syncthreads();
#pragma unroll 1
        for (int ch = 0; ch < 36; ++ch) {
            if (ch + 1 < 36) DC_LOAD(ch + 1, n);
            const unsigned char* stc = smem + D_ST + (ch & 1) * 32 * DS_PITCH; unsigned char* stn = smem + D_ST + ((ch + 1) & 1) * 32 * DS_PITCH;
            f32x4 accW = (f32x4){0.f, 0.f, 0.f, 0.f}, accQ = accW;
            { const unsigned char* sb = stc + (16 * ct + r16) * DS_PITCH + 8 * q4 * 2;
              const bf16x8 s0 = *(const bf16x8*)(sb), s1 = *(const bf16x8*)(sb + 64), s2 = *(const bf16x8*)(sb + 128), s3 = *(const bf16x8*)(sb + 192);
              accW = MFMA16(__builtin_bit_cast(bf16x8, wf0), s0, accW); accW = MFMA16(__builtin_bit_cast(bf16x8, wf1), s1, accW); accW = MFMA16(__builtin_bit_cast(bf16x8, wf2), s2, accW); accW = MFMA16(__builtin_bit_cast(bf16x8, wf3), s3, accW);
              accQ = MFMA16(__builtin_bit_cast(bf16x8, qf0), s0, accQ); accQ = MFMA16(__builtin_bit_cast(bf16x8, qf1), s1, accQ); accQ = MFMA16(__builtin_bit_cast(bf16x8, qf2), s2, accQ); accQ = MFMA16(__builtin_bit_cast(bf16x8, qf3), s3, accQ); }
            { const float v0 = bf2f(uf.x & 0xffffu) - accW[0], v1 = __uint_as_float(uf.x & 0xffff0000u) - accW[1], v2 = bf2f(uf.y & 0xffffu) - accW[2], v3 = __uint_as_float(uf.y & 0xffff0000u) - accW[3];
              uint2 o; o.x = pk2(v0, v1); o.y = pk2(v2, v3);
              *(uint2*)(smem + D_VN + (16 * ct + r16) * DV_PITCH + (16 * rt + 4 * q4) * 2) = o; }
            __syncthreads();
            { const unsigned char* vb = smem + D_VN + (16 * ct + r16) * DV_PITCH + 8 * q4 * 2;
              const bf16x8 v0 = *(const bf16x8*)(vb), v1 = *(const bf16x8*)(vb + 64);
              accQ = MFMA16(__builtin_bit_cast(bf16x8, qk0), v0, accQ); accQ = MFMA16(__builtin_bit_cast(bf16x8, qk1), v1, accQ);
              const float egl = ((const float*)(smem + D_EG))[ch];
              Sacc[0] = Sacc[0] * egl; Sacc[1] = Sacc[1] * egl;
              Sacc[0] = MFMA16(__builtin_bit_cast(bf16x8, kd00), v0, Sacc[0]); Sacc[0] = MFMA16(__builtin_bit_cast(bf16x8, kd01), v1, Sacc[0]);
              Sacc[1] = MFMA16(__builtin_bit_cast(bf16x8, kd10), v0, Sacc[1]); Sacc[1] = MFMA16(__builtin_bit_cast(bf16x8, kd11), v1, Sacc[1]); }
            wf0 = nwf0; wf1 = nwf1; wf2 = nwf2; wf3 = nwf3; qf0 = nqf0; qf1 = nqf1; qf2 = nqf2; qf3 = nqf3; qk0 = nqk0; qk1 = nqk1; kd00 = nkd00; kd01 = nkd01; kd10 = nkd10; kd11 = nkd11; uf = nuf;
            asm volatile("" ::: "memory");
            { float* ob = (float*)(smem + D_OB) + ((ch % 12) * 64 + 16 * rt + 4 * q4) * 32 + 16 * ct + r16;
#pragma unroll
              for (int j = 0; j < 4; ++j) ob[j * 32] = accQ[j]; }
#pragma unroll
            for (int tt = 0; tt < 2; ++tt) { uint2 o; o.x = pk2(Sacc[tt][0], Sacc[tt][1]); o.y = pk2(Sacc[tt][2], Sacc[tt][3]);
                *(uint2*)(stn + (16 * ct + r16) * DS_PITCH + (32 * rt + 16 * tt + 4 * q4) * 2) = o; }
            __syncthreads();
            if (ch % 12 == 11) {
                const float* obf = (const float*)(smem + D_OB);
#pragma unroll 2
                for (int i = 0; i < 6; ++i) { const int idx = tid + i * NTHR, pos = idx >> 2, seg = idx & 3;
                    const float4 v0 = *(const float4*)(obf + pos * 32 + seg * 8), v1 = *(const float4*)(obf + pos * 32 + seg * 8 + 4);
                    uint4 o; o.x = pk2(v0.x, v0.y); o.y = pk2(v0.z, v0.w); o.z = pk2(v1.x, v1.y); o.w = pk2(v1.z, v1.w);
                    *(uint4*)(ODN + ((size_t)dir * T_ALL + seq_row(b, dir, (ch - 11) * 64 + pos)) * 512 + h * 128 + sl * 32 + seg * 8) = o; }
            }
        }
    }
#undef DC_CIDX
#undef DC_LOAD
}

DI bf16x8 pack_step(const f32x16& x, int s) {
    u32x4 q;
    asm volatile("v_cvt_pk_bf16_f32 %0, %4, %5\n\tv_cvt_pk_bf16_f32 %1, %6, %7\n\tv_cvt_pk_bf16_f32 %2, %8, %9\n\tv_cvt_pk_bf16_f32 %3, %10, %11\n\ts_nop 1"
                 : "=&v"(q[0]), "=&v"(q[1]), "=&v"(q[2]), "=&v"(q[3])
                 : "v"(x[8 * s]), "v"(x[8 * s + 1]), "v"(x[8 * s + 2]), "v"(x[8 * s + 3]), "v"(x[8 * s + 4]), "v"(x[8 * s + 5]), "v"(x[8 * s + 6]), "v"(x[8 * s + 7]));
    return __builtin_bit_cast(bf16x8, q);
}
constexpr int KPITCH = 272, VPITCH = 136, KBUF_B = 64 * KPITCH, VBUF_B = 128 * VPITCH;
DI void phase_attn(PrmC p, int ai, int layer, int n_items, unsigned char* smem) {
    const bf16_t* QD = (const bf16_t*)(p->ws + OFF_QD); const bf16_t* KD = (const bf16_t*)(p->ws + OFF_KD); const bf16_t* VT = (const bf16_t*)(p->ws + OFF_VT);
    bf16_t* Y = (bf16_t*)(p->ws + OFF_HY);
    const int tid = opaque_tid(), lane = tid & 63, wave = tid >> 6, qg = wave & 3, map = wave >> 2, r = lane & 31, hh = lane >> 5;
    asm volatile("" : "+s"(layer));
    float lam_full; const float lambda_init = 0.8f - 0.6f * __expf(-0.3f * (float)layer);
    { const float* lm = p->diff_lambda + (size_t)ai * 256; const float s1 = wave_sum(lm[lane] * lm[64 + lane]), s2 = wave_sum(lm[128 + lane] * lm[192 + lane]);
      lam_full = __expf(s1) - __expf(s2) + lambda_init; }
    unsigned char* kb0 = smem; unsigned char* vb0 = smem + 2 * KBUF_B;
    float* xch = (float*)smem;
    for (int item0 = bid(); item0 < n_items; item0 += gdim()) {
        int item = item0;
        if (gdim() == 256 && item0 < 512) { const int blk = item0 & 255, li = (item0 >> 8) * 32 + (blk >> 3); item = (((blk & 7) * 4 + (li >> 4)) << 4) + (li & 15); }
        int b, h, qpos0, nkt;
        if (item < 512) { b = item >> 6; h = (item >> 4) & 3; qpos0 = 256 + (item & 15) * 128; nkt = 36; }
        else { const int j = item - 512; b = j >> 3; h = (j >> 1) & 3; qpos0 = (j & 1) * 128; nkt = 4; }
        const int bh = b * 4 + h;
        const bf16_t* Kg = KD + (size_t)bh * 2304 * 128; const bf16_t* Vg = VT + (size_t)bh * 128 * 2304;
        bf16x8 qf[4];
        { const bf16_t* qp = QD + ((size_t)bh * 2304 + qpos0 + 32 * qg + r) * 128 + map * 64 + 8 * hh;
#pragma unroll
          for (int ks = 0; ks < 4; ++ks) qf[ks] = *(const bf16x8*)(qp + 16 * ks); }
        f32x16 O[4];
#pragma unroll
        for (int nt = 0; nt < 4; ++nt)
#pragma unroll
            for (int i = 0; i < 16; ++i) O[nt][i] = 0.f;
        float m = -1e30f, lsum = 0.f;
        uint4 kreg0, kreg1, vreg0, vreg1;
#define ATT_G1(i_, KR_, VR_, kt) { const int idx_ = tid + (i_) * NTHR; \
            KR_ = *(const uint4*)(Kg + (size_t)((kt) * 64 + (idx_ >> 4)) * 128 + (idx_ & 15) * 8); \
            VR_ = *(const uint4*)(Vg + (size_t)(idx_ >> 3) * 2304 + (kt) * 64 + (idx_ & 7) * 8); }
#define ATT_GLOAD(kt) do { ATT_G1(0, kreg0, vreg0, kt) ATT_G1(1, kreg1, vreg1, kt) } while (0)
#define ATT_S1(i_, KR_, VR_, bi) { const int idx_ = tid + (i_) * NTHR; \
            *(uint4*)(kb0 + (bi) * KBUF_B + (idx_ >> 4) * KPITCH + (idx_ & 15) * 16) = KR_; \
            *(uint2*)(vb0 + (bi) * VBUF_B + (idx_ >> 3) * VPITCH + (idx_ & 7) * 16) = make_uint2(VR_.x, VR_.y); *(uint2*)(vb0 + (bi) * VBUF_B + (idx_ >> 3) * VPITCH + (idx_ & 7) * 16 + 8) = make_uint2(VR_.z, VR_.w); }
#define ATT_LSTORE(bi) do { ATT_S1(0, kreg0, vreg0, bi) ATT_S1(1, kreg1, vreg1, bi) } while (0)
        __syncthreads();
        ATT_GLOAD(0); ATT_LSTORE(0);
        __syncthreads();
        for (int kt = 0; kt < nkt; ++kt) {
            const unsigned char* kb = kb0 + (kt & 1) * KBUF_B; const unsigned char* vb = vb0 + (kt & 1) * VBUF_B;
            if (kt + 1 < nkt) ATT_GLOAD(kt + 1);
            {
                f32x16 S0, S1;
#pragma unroll
                for (int i = 0; i < 16; ++i) { S0[i] = 0.f; S1[i] = 0.f; }
#pragma unroll
                for (int ks = 0; ks < 4; ++ks) {
                    const bf16x8 a0 = *(const bf16x8*)(kb + r * KPITCH + map * 128 + (16 * ks + 8 * hh) * 2);
                    const bf16x8 a1 = *(const bf16x8*)(kb + (32 + r) * KPITCH + map * 128 + (16 * ks + 8 * hh) * 2);
                    S0 = MFMA32(a0, qf[ks], S0); S1 = MFMA32(a1, qf[ks], S1); }
                float tmax = fmaxf(S0[0], S1[0]);
#pragma unroll
                for (int i = 1; i < 16; ++i) tmax = fmaxf(tmax, fmaxf(S0[i], S1[i]));
                if (__any(tmax > m + 8.0f)) {
                    tmax = fmaxf(tmax, __shfl_xor(tmax, 32));
                    const float mn = fmaxf(m, tmax), alpha = __builtin_amdgcn_exp2f(m - mn);
                    m = mn; lsum *= alpha;
#pragma unroll
                    for (int nt = 0; nt < 4; ++nt)
#pragma unroll
                        for (int i = 0; i < 16; ++i) O[nt][i] *= alpha;
                }
#pragma unroll
                for (int i = 0; i < 16; ++i) { S0[i] = __builtin_amdgcn_exp2f(S0[i] - m); S1[i] = __builtin_amdgcn_exp2f(S1[i] - m); lsum += S0[i] + S1[i]; }
#pragma unroll
                for (int sub = 0; sub < 2; ++sub)
#pragma unroll
                    for (int s = 0; s < 2; ++s) {
                        const bf16x8 pb = pack_step(sub ? S1 : S0, s);
#pragma unroll
                        for (int nt = 0; nt < 4; ++nt) {
                            const unsigned char* va = vb + (32 * nt + r) * VPITCH + (32 * sub + 16 * s + 4 * hh) * 2;
                            const uint2 lo = *(const uint2*)va, hi = *(const uint2*)(va + 16);
                            const uint4 av = make_uint4(lo.x, lo.y, hi.x, hi.y);
                            O[nt] = MFMA32(__builtin_bit_cast(bf16x8, av), pb, O[nt]);
                        }
                    }
            }
            if (kt + 1 < nkt) ATT_LSTORE((kt + 1) & 1);
            __syncthreads();
        }
        lsum += __shfl_xor(lsum, 32);
        const float inv = 1.0f / lsum;
        if (map == 1) {
            const float sc = lam_full * inv;
#pragma unroll
            for (int nt = 0; nt < 4; ++nt)
#pragma unroll
                for (int i = 0; i < 16; ++i) xch[(qg * 128 + 32 * nt + (i & 3) + 8 * (i >> 2) + 4 * hh) * 32 + r] = O[nt][i] * sc;
        }
        __syncthreads();
        if (map == 0) {
            float ss = 0.f;
#pragma unroll
            for (int nt = 0; nt < 4; ++nt)
#pragma unroll
                for (int i = 0; i < 16; ++i) { const float o = O[nt][i] * inv - xch[(qg * 128 + 32 * nt + (i & 3) + 8 * (i >> 2) + 4 * hh) * 32 + r]; O[nt][i] = o; ss += o * o; }
            ss += __shfl_xor(ss, 32);
            const float rstd = rsqrtf(ss * (1.0f / 128.0f) + 1e-6f) * (1.0f - lambda_init);
            const int pos = qpos0 + 32 * qg + r;
            const int row = pos >= 256 ? b * 2048 + (pos - 256) : T_LAT + b * 256 + pos;
            const float* sw = p->diff_subln_w + (size_t)ai * 128;
            bf16_t* yo = row < T_LAT ? Y + (size_t)row * 1024 + 512 + h * 128 : Y + (size_t)T_LAT * 1024 + ((size_t)2048 + (row - T_LAT)) * 512 + h * 128;
#pragma unroll
            for (int nt = 0; nt < 4; ++nt)
#pragma unroll
                for (int g4 = 0; g4 < 4; ++g4) { const int dv = 32 * nt + 8 * g4 + 4 * hh; const float4 w = *(const float4*)(sw + dv);
                    uint2 o; o.x = pk2(O[nt][4 * g4 + 0] * rstd * w.x, O[nt][4 * g4 + 1] * rstd * w.y); o.y = pk2(O[nt][4 * g4 + 2] * rstd * w.z, O[nt][4 * g4 + 3] * rstd * w.w);
                    *(uint2*)(yo + dv) = o; }
        }
    }
#undef ATT_GLOAD
#undef ATT_LSTORE
}

DI void phase_dn_merge(PrmC p, int ai, int nrows, int gw, int NGW) {
    const bf16_t* ODN = (const bf16_t*)(p->ws + OFF_ODN); const bf16_t* P = (const bf16_t*)(p->ws + OFF_ABP); bf16_t* Y = (bf16_t*)(p->ws + OFF_HY);
    const int lane = opaque_tid() & 63;
    const float* nw = p->dn_norm_w + (size_t)ai * 128 + (lane & 15) * 8;
    const float4 w0 = *(const float4*)nw, w1 = *(const float4*)(nw + 4);
    const float wv[8] = {w0.x, w0.y, w0.z, w0.w, w1.x, w1.y, w1.z, w1.w};
    for (int rowa = gw; rowa < nrows; rowa += 2 * NGW) {
        const int rowb = rowa + NGW < nrows ? rowa + NGW : rowa;
        const uint4 a0 = *(const uint4*)(ODN + (size_t)rowa * 512 + lane * 8), a1 = *(const uint4*)(ODN + ((size_t)T_ALL + rowa) * 512 + lane * 8), za = *(const uint4*)(P + (size_t)rowa * 3840 + 1536 + lane * 8);
        const uint4 b0 = *(const uint4*)(ODN + (size_t)rowb * 512 + lane * 8), b1 = *(const uint4*)(ODN + ((size_t)T_ALL + rowb) * 512 + lane * 8), zb = *(const uint4*)(P + (size_t)rowb * 3840 + 1536 + lane * 8);
#pragma unroll
        for (int rr = 0; rr < 2; ++rr) {
            const int row = rr ? rowb : rowa;
            float o[8], o2[8], z[8]; unpack8(rr ? b0 : a0, o); unpack8(rr ? b1 : a1, o2); unpack8(rr ? zb : za, z);
            float ss = 0.f;
#pragma unroll
            for (int e = 0; e < 8; ++e) { o[e] += o2[e]; ss += o[e] * o[e]; }
            ss = sum16(ss);
            const float rstd = rsqrtf(ss * (1.0f / 128.0f) + 1e-6f);
            float y[8];
#pragma unroll
            for (int e = 0; e < 8; ++e) y[e] = o[e] * rstd * wv[e] * silu_f(z[e]);
            *(uint4*)(row < T_LAT ? Y + (size_t)row * 1024 + lane * 8 : Y + (size_t)T_LAT * 1024 + (size_t)(row - T_LAT) * 512 + lane * 8) = pack8(y);
        }
    }
}

DI void phase_ret_prep(PrmC p, int ri, unsigned char* smem) {
    const bf16_t* P0 = (const bf16_t*)(p->ws + OFF_RP); const bf16_t* P1 = P0 + RP_STRIDE;
    bf16_t* QR = (bf16_t*)(p->ws + OFF_QR); bf16_t* KR = (bf16_t*)(p->ws + OFF_KR);
    bf16_t* KDT = (bf16_t*)(p->ws + OFF_KDT); bf16_t* VTR = (bf16_t*)(p->ws + OFF_VTR);
    const float2* RT = (const float2*)(p->ws + OFF_ROPE_RET);
    bf16_t* kt_l = (bf16_t*)smem;
    bf16_t* vt_l = (bf16_t*)(smem + 64 * 528);
    float* dec_l = (float*)(smem + 64 * 528 + 64 * 1040);
    const int tid = opaque_tid(), lane = tid & 63, wave = tid >> 6;
    for (int item = bid(); item < 288 * 4; item += gdim()) {
        const int g = item >> 2, hp = item & 3, row0 = g * 64; const bool lat = row0 < T_LAT;
        __syncthreads();
#pragma unroll
        for (int i = 0; i < 8; ++i) { const int idx = tid + i * NTHR, pos = idx >> 6, seg = idx & 63;
            *(uint4*)(vt_l + pos * 520 + seg * 8) = *(const uint4*)(P1 + (size_t)(row0 + pos) * 2048 + hp * 512 + seg * 8); }
        if (tid < 256) { const int j = tid & 63, hh2 = (tid >> 6) & 1, dir2 = tid >> 7; const float dl = p->ret_decay_logit[(size_t)ri * 16 + dir2 * 8 + 2 * hp + hh2];
            dec_l[tid] = exp2f(-log1pf(__expf(-dl)) * 1.4426950408889634f * (float)(dir2 ? j : 63 - j)); }
        { const int l32 = lane & 31, c = l32 * 8, wo = c & 127; const bool firsth = wo < 64;
#pragma unroll 2
          for (int tp = 0; tp < 4; ++tp) {
              const int pos = 8 * wave + 2 * tp + (lane >> 5), row = row0 + pos;
              float q[8], k[8]; unpack8(*(const uint4*)(P0 + (size_t)row * 2048 + hp * 256 + c), q); unpack8(*(const uint4*)(P0 + (size_t)row * 2048 + 1024 + hp * 256 + c), k);
              if (lat) {
                  const float2* rt = RT + (size_t)(row & 2047) * 64 + (wo & 63);
#pragma unroll
                  for (int e = 0; e < 8; ++e) { const float2 cs = rt[e]; const float qp = __shfl_xor(q[e], 8), kp = __shfl_xor(k[e], 8);
                      q[e] = q[e] * cs.x + (firsth ? -qp : qp) * cs.y; k[e] = k[e] * cs.x + (firsth ? -kp : kp) * cs.y; }
              }
#pragma unroll
              for (int e = 0; e < 8; ++e) k[e] *= 0.08838834764831845f;
              const uint4 kq = pack8(k);
              *(uint4*)(QR + (size_t)row * 1024 + hp * 256 + c) = pack8(q); *(uint4*)(KR + (size_t)row * 1024 + hp * 256 + c) = kq;
              *(uint4*)(kt_l + pos * 264 + c) = kq;
          } }
        __syncthreads();
#pragma unroll 2
        for (int i = 0; i < 8; ++i) {
            const int q = tid + i * NTHR, dk = q & 127, pg = (q >> 7) & 7, hh = (q >> 10) & 1, dir = (q >> 11) & 1, h = 2 * hp + hh;
            float v[8];
#pragma unroll
            for (int e = 0; e < 8; ++e) { const int j = 8 * pg + e; v[e] = bf2f(kt_l[j * 264 + hh * 128 + dk]) * dec_l[(dir * 2 + hh) * 64 + j]; }
            *(uint4*)(KDT + ((((size_t)dir * 288 + g) * 8 + h) * 128 + dk) * 64 + 8 * pg) = pack8(v);
        }
#pragma unroll 2
        for (int i = 0; i < 8; ++i) {
            const int q = tid + i * NTHR, dvi = q & 255, pg = (q >> 8) & 7, hh = q >> 11, h = 2 * hp + hh;
            unsigned w[4];
#pragma unroll
            for (int e = 0; e < 4; ++e) w[e] = (unsigned)vt_l[(8 * pg + 2 * e) * 520 + hh * 256 + dvi] | ((unsigned)vt_l[(8 * pg + 2 * e + 1) * 520 + hh * 256 + dvi] << 16);
            *(uint4*)(VTR + (((size_t)g * 8 + h) * 256 + dvi) * 64 + 8 * pg) = make_uint4(w[0], w[1], w[2], w[3]);
        }
    }
}

constexpr int RQ_PITCH = 272, RT_PITCH = 144;
constexpr int R_QL = 0, R_KL = 64 * RQ_PITCH, R_KTL = 2 * 64 * RQ_PITCH, R_VTL = R_KTL + 128 * RT_PITCH, R_ST = R_VTL + 128 * RT_PITCH;
DI void phase_ret_chunk(PrmC p, int ri, unsigned char* smem, bool skip_ctx_out) {
    const bf16_t* QR = (const bf16_t*)(p->ws + OFF_QR); const bf16_t* KR = (const bf16_t*)(p->ws + OFF_KR);
    const bf16_t* KDT = (const bf16_t*)(p->ws + OFF_KDT); const bf16_t* VTR = (const bf16_t*)(p->ws + OFF_VTR);
    bf16_t* ORp = (bf16_t*)(p->ws + OFF_OR);
    const int tid = opaque_tid(), lane = tid & 63, wave = tid >> 6, r = lane & 31, hh = lane >> 5;
    const int dvt = wave >> 1, it = wave & 1, dkt = wave >> 1, dv2 = 2 * (wave & 1);
    typedef __attribute__((address_space(3))) unsigned char* lbp;
    unsigned stb_ = R_ST; asm volatile("" : "+v"(stb_)); const lbp stl = (lbp)(uintptr_t)stb_;
    for (int item0 = bid(); item0 < 256; item0 += gdim()) {
        const int item = xcd_group_item(item0, gdim());
        const int sl = item & 1, dir = (item >> 1) & 1, h = (item >> 2) & 7, b = item >> 5;
        const float dl = p->ret_decay_logit[(size_t)ri * 16 + dir * 8 + h];
        const float lg2 = -log1pf(__expf(-dl)) * 1.4426950408889634f;
        const float cdec = exp2f(lg2 * 64.0f);
        const int ii = 32 * it + r;
        const float rowscale = exp2f(lg2 * (float)(dir ? 64 - ii : ii + 1));
        __attribute__((address_space(3))) float* gtab = (__attribute__((address_space(3))) float*)(stl + 128 * RQ_PITCH);
        __syncthreads();
        if (tid < 32) { const int rg = tid & 15, h2 = tid >> 4, jl = (rg & 3) + 8 * (rg >> 2) + 4 * h2; gtab[tid] = exp2f(lg2 * (float)(dir ? jl : -jl)); }
        const float gi0 = exp2f(lg2 * (float)(dir ? -ii : ii)), gi1 = gi0 * exp2f(lg2 * (dir ? 32.0f : -32.0f));
        f32x16 Sacc[2];
#pragma unroll
        for (int t = 0; t < 2; ++t)
#pragma unroll
            for (int i = 0; i < 16; ++i) Sacc[t][i] = 0.f;
        uint4 q0, q1, k0, k1, t0, t1, v0, v1;
#define RC_ROW0(ch) ((ch) < 4 ? T_LAT + b * 256 + (dir ? 3 - (ch) : (ch)) * 64 : b * 2048 + (dir ? 35 - (ch) : (ch) - 4) * 64)
#define RC_GLOAD(ch) do { const int row0_ = RC_ROW0(ch), g_ = row0_ >> 6; \
            { const int idx_ = tid, pos_ = idx_ >> 4, seg_ = idx_ & 15; q0 = *(const uint4*)(QR + (size_t)(row0_ + pos_) * 1024 + h * 128 + seg_ * 8); k0 = *(const uint4*)(KR + (size_t)(row0_ + pos_) * 1024 + h * 128 + seg_ * 8); } \
            { const int idx_ = tid + NTHR, pos_ = idx_ >> 4, seg_ = idx_ & 15; q1 = *(const uint4*)(QR + (size_t)(row0_ + pos_) * 1024 + h * 128 + seg_ * 8); k1 = *(const uint4*)(KR + (size_t)(row0_ + pos_) * 1024 + h * 128 + seg_ * 8); } \
            { const bf16_t* kd_ = KDT + (((size_t)dir * 288 + g_) * 8 + h) * 8192; const bf16_t* vt_ = VTR + (((size_t)g_ * 8 + h) * 256 + sl * 128) * 64; \
              t0 = *(const uint4*)(kd_ + tid * 8); t1 = *(const uint4*)(kd_ + (tid + NTHR) * 8); v0 = *(const uint4*)(vt_ + tid * 8); v1 = *(const uint4*)(vt_ + (tid + NTHR) * 8); } } while (0)
#define RC_LSTORE() do { \
            { const int idx_ = tid, pos_ = idx_ >> 4, seg_ = idx_ & 15; *(uint4*)(smem + R_QL + pos_ * RQ_PITCH + seg_ * 16) = q0; *(uint4*)(smem + R_KL + pos_ * RQ_PITCH + seg_ * 16) = k0; } \
            { const int idx_ = tid + NTHR, pos_ = idx_ >> 4, seg_ = idx_ & 15; *(uint4*)(smem + R_QL + pos_ * RQ_PITCH + seg_ * 16) = q1; *(uint4*)(smem + R_KL + pos_ * RQ_PITCH + seg_ * 16) = k1; } \
            { const int idx_ = tid, rw_ = idx_ >> 3, seg_ = idx_ & 7; *(uint4*)(smem + R_KTL + rw_ * RT_PITCH + seg_ * 16) = t0; *(uint4*)(smem + R_VTL + rw_ * RT_PITCH + seg_ * 16) = v0; } \
            { const int idx_ = tid + NTHR, rw_ = idx_ >> 3, seg_ = idx_ & 7; *(uint4*)(smem + R_KTL + rw_ * RT_PITCH + seg_ * 16) = t1; *(uint4*)(smem + R_VTL + rw_ * RT_PITCH + seg_ * 16) = v1; } } while (0)
        __syncthreads();
        for (int i = tid; i < 128 * RQ_PITCH / 16; i += NTHR) *(__attribute__((address_space(3))) u32x4*)(stl + i * 16) = (u32x4){0u, 0u, 0u, 0u};
        RC_GLOAD(0);
        for (int ch = 0; ch < 36; ++ch) {
            RC_LSTORE();
            __syncthreads();
            const int row0 = RC_ROW0(ch);
            if (ch + 1 < 36) RC_GLOAD(ch + 1);
            if (!(skip_ctx_out && ch < 4)) {
            int iil = ii; asm volatile("" : "+v"(iil));
            const bool use0 = dir ? (it == 0) : true, use1 = dir ? true : (it == 1);
            f32x16 acc, Sx0, Sx1;
#pragma unroll
            for (int i = 0; i < 16; ++i) { acc[i] = 0.f; Sx0[i] = 0.f; Sx1[i] = 0.f; }
#pragma unroll
            for (int ks = 0; ks < 8; ++ks) {
                const bf16x8 qf = *(const bf16x8*)(smem + R_QL + ii * RQ_PITCH + (16 * ks + 8 * hh) * 2);
                const bf16x8 a = *(const __attribute__((address_space(3))) bf16x8*)(stl + (32 * dvt + r) * RQ_PITCH + (16 * ks + 8 * hh) * 2);
                acc = MFMA32(a, qf, acc);
                if (use0) { const bf16x8 k0f = *(const bf16x8*)(smem + R_KL + r * RQ_PITCH + (16 * ks + 8 * hh) * 2); Sx0 = MFMA32(k0f, qf, Sx0); }
                if (use1) { const bf16x8 k1f = *(const bf16x8*)(smem + R_KL + (32 + r) * RQ_PITCH + (16 * ks + 8 * hh) * 2); Sx1 = MFMA32(k1f, qf, Sx1); }
            }
#pragma unroll
            for (int i = 0; i < 16; ++i) acc[i] *= rowscale;
            if (use0) {
#pragma unroll
                for (int i = 0; i < 16; ++i) { const int j = (i & 3) + 8 * (i >> 2) + 4 * hh; const bool keep = dir ? (j >= iil) : (iil >= j); Sx0[i] = keep ? Sx0[i] * (gi0 * gtab[hh * 16 + i]) : 0.f; }
#pragma unroll
                for (int s = 0; s < 2; ++s) {
                    const bf16x8 pb = pack_step(Sx0, s);
                    const unsigned char* va = smem + R_VTL + (32 * dvt + r) * RT_PITCH + (16 * s + 4 * hh) * 2;
                    const uint2 lo = *(const uint2*)va, hi = *(const uint2*)(va + 16);
                    acc = MFMA32(__builtin_bit_cast(bf16x8, make_uint4(lo.x, lo.y, hi.x, hi.y)), pb, acc);
                }
            }
            if (use1) {
#pragma unroll
                for (int i = 0; i < 16; ++i) { const int j = 32 + (i & 3) + 8 * (i >> 2) + 4 * hh; const bool keep = dir ? (j >= iil) : (iil >= j); Sx1[i] = keep ? Sx1[i] * (gi1 * gtab[hh * 16 + i]) : 0.f; }
#pragma unroll
                for (int s = 0; s < 2; ++s) {
                    const bf16x8 pb = pack_step(Sx1, s);
                    const unsigned char* va = smem + R_VTL + (32 * dvt + r) * RT_PITCH + (32 + 16 * s + 4 * hh) * 2;
                    const uint2 lo = *(const uint2*)va, hi = *(const uint2*)(va + 16);
                    acc = MFMA32(__builtin_bit_cast(bf16x8, make_uint4(lo.x, lo.y, hi.x, hi.y)), pb, acc);
                }
            }
            { bf16_t* op = ORp + ((size_t)dir * T_ALL + row0 + ii) * 2048 + h * 256 + sl * 128 + 32 * dvt + 4 * hh;
#pragma unroll
              for (int g4 = 0; g4 < 4; ++g4) { uint2 o; o.x = cvt_pk_bf16(acc[4 * g4], acc[4 * g4 + 1]); o.y = cvt_pk_bf16(acc[4 * g4 + 2], acc[4 * g4 + 3]); *(uint2*)(op + 8 * g4) = o; } }
            }
#pragma unroll
            for (int t = 0; t < 2; ++t) {
#pragma unroll
                for (int i = 0; i < 16; ++i) Sacc[t][i] *= cdec;
#pragma unroll
                for (int ks = 0; ks < 4; ++ks) {
                    const bf16x8 a = *(const bf16x8*)(smem + R_KTL + (32 * dkt + r) * RT_PITCH + (16 * ks + 8 * hh) * 2);
                    const bf16x8 bb = *(const bf16x8*)(smem + R_VTL + (32 * (dv2 + t) + r) * RT_PITCH + (16 * ks + 8 * hh) * 2);
                    Sacc[t] = MFMA32(a, bb, Sacc[t]);
                }
            }
            __syncthreads();
#pragma unroll
            for (int t = 0; t < 2; ++t)
#pragma unroll
                for (int g4 = 0; g4 < 4; ++g4) { u32x2_t o; o.x = cvt_pk_bf16(Sacc[t][4 * g4], Sacc[t][4 * g4 + 1]); o.y = cvt_pk_bf16(Sacc[t][4 * g4 + 2], Sacc[t][4 * g4 + 3]);
                    *(__attribute__((address_space(3))) u32x2_t*)(stl + (32 * (dv2 + t) + r) * RQ_PITCH + (32 * dkt + 8 * g4 + 4 * hh) * 2) = o; }
        }
    }
#undef RC_ROW0
#undef RC_GLOAD
#undef RC_LSTORE
}

DI void phase_ret_merge(PrmC p, int nrows, int gw, int NGW) {
    const bf16_t* ORp = (const bf16_t*)(p->ws + OFF_OR); const bf16_t* PG = (const bf16_t*)(p->ws + OFF_RP) + 2 * RP_STRIDE; bf16_t* Y = (bf16_t*)(p->ws + OFF_HY);
    const int lane = opaque_tid() & 63;
    for (int row = gw; row < nrows; row += NGW) {
        uint4 ra[4], rc[4], rz[4];
#pragma unroll
        for (int g = 0; g < 4; ++g) { const size_t off = (size_t)row * 2048 + g * 512 + lane * 8;
            ra[g] = *(const uint4*)(ORp + off); rc[g] = *(const uint4*)(ORp + (size_t)T_ALL * 2048 + off); rz[g] = *(const uint4*)(PG + off); }
#pragma unroll
        for (int g = 0; g < 4; ++g) {
            const size_t off = (size_t)row * 2048 + g * 512 + lane * 8;
            float a[8], c[8], z[8]; unpack8(ra[g], a); unpack8(rc[g], c); unpack8(rz[g], z);
            float ss = 0.f;
#pragma unroll
            for (int e = 0; e < 8; ++e) { a[e] += c[e]; ss += a[e] * a[e]; }
            ss = sum16(ss); ss += __shfl_xor(ss, 16);
            const float rstd = rsqrtf(ss * (1.0f / 256.0f) + 1e-6f);
#pragma unroll
            for (int e = 0; e < 8; ++e) a[e] = a[e] * rstd * silu_f(z[e]);
            *(uint4*)(row < T_LAT ? Y + off : Y + (size_t)T_LAT * 2048 + ((size_t)(g >> 1) * 2048 + (row - T_LAT)) * 1024 + (g & 1) * 512 + lane * 8) = pack8(a);
        }
    }
}

DI void phase_final(PrmC p, int gw, int NGW) {
    const float* X = (const float*)(p->ws + OFF_X);
    const int lane = opaque_tid() & 63;
    for (int row = gw; row < T_LAT; row += NGW) {
        const float* xr = X + (size_t)row * 1024;
        float4 v[4]; float ss = 0.f;
#pragma unroll
        for (int j = 0; j < 4; ++j) { v[j] = *(const float4*)(xr + j * 256 + lane * 4); ss += v[j].x * v[j].x + v[j].y * v[j].y + v[j].z * v[j].z + v[j].w * v[j].w; }
        const float rstd = rsqrtf(wave_sum(ss) * (1.0f / 1024.0f) + 1e-6f);
#pragma unroll
        for (int j = 0; j < 4; ++j) { const int c = j * 256 + lane * 4; const float4 w = *(const float4*)(p->final_norm_w + c);
            *(float4*)(p->out + (size_t)row * 1024 + c) = make_float4(v[j].x * rstd * w.x, v[j].y * rstd * w.y, v[j].z * rstd * w.z, v[j].w * rstd * w.w); }
    }
}


#define LAS __attribute__((address_space(3)))
#define XB_TMO      128
#define XB_XCNT(j)  (256  + 64 * (j))
#define XB_XSUB(j)  (1280 + 64 * (j))
#define XB_XGEN(j)  (2304 + 64 * (j))
#define XB_TOP      3328
#define XB_TOPGEN   3392
#define XCD_BAR_WORDS 3456
#define XB_SPIN_CAP (1u << 18)

__device__ __forceinline__ unsigned xb_ld(unsigned* p)              { return __hip_atomic_load(p, __ATOMIC_RELAXED, __HIP_MEMORY_SCOPE_AGENT); }
__device__ __forceinline__ unsigned xb_add(unsigned* p, unsigned v) { return __hip_atomic_fetch_add(p, v, __ATOMIC_RELAXED, __HIP_MEMORY_SCOPE_AGENT); }
__device__ __forceinline__ unsigned xb_xcc_id() { return (unsigned)__builtin_amdgcn_s_getreg((3 << 11) | 20) & 0xFu; }
#define XB_SPIN(cond, bar) do { unsigned _sp = 0; while (cond) { __builtin_amdgcn_s_sleep(1); \
    if ((++_sp & 255u) == 0u) { if (xb_ld(&(bar)[XB_TMO])) break; if (_sp > XB_SPIN_CAP) { atomicAdd(&(bar)[XB_TMO], 1u); break; } } } } while (0)

struct XcdBarrier {
    unsigned* bar; unsigned x;
    volatile LAS unsigned* st;
};

__device__ __forceinline__ XcdBarrier xcd_barrier_post(unsigned* bar, volatile LAS unsigned* st) {
    XcdBarrier b; b.bar = bar; b.x = xb_xcc_id(); b.st = st;
    if (threadIdx.x == 0) (void)xb_add(&bar[XB_XCNT(b.x)], 1u);
    return b;
}
__device__ __forceinline__ void xcd_barrier_complete(unsigned* bar, unsigned x, unsigned& nloc, unsigned& nx) {
    const unsigned G = gridDim.x * gridDim.y * gridDim.z;
    unsigned sum, cnt, mine, sp = 0u;
    for (;;) {
        sum = 0u; cnt = 0u; mine = 0u;
#pragma unroll
        for (unsigned j = 0; j < 16; ++j) { const unsigned c = xb_ld(&bar[XB_XCNT(j)]); sum += c; cnt += (c > 0u) ? 1u : 0u; mine = (j == x) ? c : mine; }
        if (sum == G) break;
        __builtin_amdgcn_s_sleep(1);
        if ((++sp & 255u) == 0u) { if (xb_ld(&bar[XB_TMO])) break; if (sp > XB_SPIN_CAP) { atomicAdd(&bar[XB_TMO], 1u); break; } }
    }
    nloc = mine > 0u ? mine : 1u; nx = cnt > 0u ? cnt : 1u;
}

__device__ __forceinline__ void xcd_barrier(const XcdBarrier& b) {
    asm volatile("s_waitcnt vmcnt(0)" ::: "memory");
    __syncthreads();
    if (threadIdx.x == 0) {
        unsigned* bar = b.bar;
        __builtin_amdgcn_s_waitcnt(0);
        unsigned nloc = b.st[0], nx = b.st[1];
        if (nloc == 0u) { xcd_barrier_complete(bar, b.x, nloc, nx); b.st[0] = nloc; b.st[1] = nx; }
        const unsigned old = xb_add(&bar[XB_XSUB(b.x)], 1u);
        const unsigned gen = old / nloc;
        if (old + 1u == (gen + 1u) * nloc) {
            __builtin_amdgcn_fence(__ATOMIC_RELEASE, "agent");
            asm volatile("s_waitcnt vmcnt(0)" ::: "memory");
            const unsigned og = xb_add(&bar[XB_TOP], 1u);
            const unsigned tg = og / nx;
            if (og + 1u == (tg + 1u) * nx) xb_add(&bar[XB_TOPGEN], 1u);
            else XB_SPIN(xb_ld(&bar[XB_TOPGEN]) == tg, bar);
            __builtin_amdgcn_fence(__ATOMIC_ACQUIRE, "agent");
            xb_add(&bar[XB_XGEN(b.x)], 1u);
            asm volatile("s_waitcnt vmcnt(0)" ::: "memory");
        } else {
            XB_SPIN(xb_ld(&bar[XB_XGEN(b.x)]) == gen, bar);
            __builtin_amdgcn_fence(__ATOMIC_ACQUIRE, "agent");
            asm volatile("s_waitcnt vmcnt(0)" ::: "memory");
        }
    }
    __syncthreads();
}


constexpr int LDS_BYTES = 152 * 1024;
#ifndef PROBE_ST5
#define PROBE_ST5 1
#endif
#ifndef PROBE_ST6
#define PROBE_ST6 1
#endif
#ifndef PROBE_ST7
#define PROBE_ST7 1
#endif
#ifndef PROBE_ST8
#define PROBE_ST8 1
#endif
DI int probe_n(int n) { asm volatile("" : "+s"(n)); return n; }
#define PROBE_LOOP(n) _Pragma("unroll 1") for (int rep_ = 0, nrep_ = ((n) > 1 ? probe_n(n) : 1); rep_ < nrep_; ++rep_)
constexpr int N_PHASES = 1 + 4 * 13 + 1;

__global__ void __launch_bounds__(NTHR, 2) fwd_megakernel(Prm p_unused, int lo, int hi) {
    extern __shared__ __attribute__((aligned(16))) unsigned char smem[];
    cg::grid_group grid = cg::this_grid();
    { const int t0 = opaque_tid(); if (t0 < 4) ((volatile LAS unsigned*)(LAS unsigned char*)(smem + LDS_BYTES - 16))[t0] = 0u; }
    __syncthreads();
    if (hi - lo > 1) { PrmC p0 = get_prm(); (void)xcd_barrier_post((unsigned*)(p0->ws + OFF_BAR), (volatile LAS unsigned*)(LAS unsigned char*)(smem + LDS_BYTES - 16)); }
#define PHASE_LOCALS const int wave = __builtin_amdgcn_readfirstlane(opaque_tid() >> 6); const int G = gdim(), gw = bid() * 8 + wave, NGW = G * 8; float* scr = (float*)smem + wave * (64 * 68); pg8_lds_t lds = (pg8_lds_t)smem; (void)scr; (void)lds; (void)gw; (void)NGW;
    int ph = 0;
#define RUN_PHASE (ph >= lo && ph < hi)
#define END_PHASE do { if (ph >= lo && ph + 1 < hi) { \
        if (ph == lo && hi > 4096) {   asm volatile("s_waitcnt vmcnt(0)" ::: "memory"); grid.sync(); __builtin_amdgcn_fence(__ATOMIC_ACQUIRE, "agent"); asm volatile("s_waitcnt vmcnt(0)" ::: "memory"); }   \
        else { PrmC pb_ = get_prm(); XcdBarrier xb_; xb_.bar = (unsigned*)(pb_->ws + OFF_BAR); xb_.x = xb_xcc_id(); xb_.st = (volatile LAS unsigned*)(LAS unsigned char*)(smem + LDS_BYTES - 16); xcd_barrier(xb_); } } ++ph; } while (0)

    if (RUN_PHASE) { PrmC p = get_prm(); phase_mod(p, smem); __syncthreads();
        PHASE_LOCALS int rot = 0;
        const int first_free = G > 176 ? 144 : 0, vb = bid() - first_free;
        if (vb >= 0) { const int gw2 = vb * 8 + wave, NGW2 = (G - first_free) * 8;
            convert_weights<1>(p->ffn_w_in, 1024, 5632, (bf16_t*)(p->ws + OFF_WFI), scr, gw2, NGW2, rot);
            convert_weights<0>(p->ffn_w_out, 2816, 1024, (bf16_t*)(p->ws + OFF_WFO), scr, gw2, NGW2, rot, 1408, (bf16_t*)(p->ws + OFF_WFOS));
            convert_weights<2>(p->ab_w_in, 1024, 3600, (bf16_t*)(p->ws + OFF_WMI), scr, gw2, NGW2, rot); } }
    END_PHASE;

#pragma unroll 1
    for (int l = 0; l < 4; ++l) {
        const bool is_ab = (l & 1) == 0; const int mi = l >> 1; const bool last = l == 3;
#pragma unroll 1
        for (int st = 0; st < 13; ++st) {
            if (st == 8 && !is_ab) continue;
            if (RUN_PHASE) {
#ifdef DUP_MASK
              for (int rep_ = 0; rep_ < (((DUP_MASK) >> st) & 1) + 1; ++rep_) {
                if (rep_) __syncthreads();
#endif
                PrmC p = get_prm();
                PHASE_LOCALS
                float* X = (float*)(p->ws + OFF_X); const float* MOD = (const float*)(p->ws + OFF_MOD); bf16_t* HY = (bf16_t*)(p->ws + OFF_HY);
                bf16_t* WFI = (bf16_t*)(p->ws + OFF_WFI); bf16_t* WFO = (bf16_t*)(p->ws + OFF_WFO); bf16_t* WMI = (bf16_t*)(p->ws + OFF_WMI); bf16_t* WMO = (bf16_t*)(p->ws + OFF_WMO);
                const int Mrows = (last && st >= 9) ? T_LAT : T_ALL;
                const bool x_from_input = (l == 0 && st <= 2);
                const float* xlat = x_from_input ? p->x : X; const float* xctx = (l == 0 && st <= 3) ? p->ctx : X + (size_t)T_LAT * 1024;
                if (st == 0 || st == 3 || st == 10) {
#ifdef PROBE_NORM
                  for (int rep_ = 0; rep_ < 2; ++rep_) {
#endif
                    int rot = 0;
                    const float* fixgate = st == 3 ? MOD + ((size_t)l * 9 + 8) * 9216 + 2 * 1024 : ((st == 0 && l > 0) ? MOD + ((size_t)(l - 1) * 9 + 8) * 9216 + 8 * 1024 : ((st == 10 && !last) ? MOD + ((size_t)l * 9 + 8) * 9216 + 5 * 1024 : nullptr));
                    norm_rows(p, xlat, xctx, l, st == 0 ? 0 : (st == 3 ? 1 : 2), Mrows, gw, NGW, rot, fixgate, st == 10 ? 1.0f : 0.5f);
#ifdef PROBE_NORM
                  }
#endif
                } else if (st == 1 || st == 11) {
                    pg8::Gemm g{HY, st == 1 ? WFI : (bf16_t*)(p->ws + OFF_WFI2), Mrows, 5632, 1024}; pg8::StaticOrder S; S.init(Mrows, 5632, G, bid());
                    pg8::EpiSwiglu E{(bf16_t*)(p->ws + OFF_HID), 2816, (bf16_t*)(p->ws + OFF_HIDC)};
                    pg8::gemm_phase<pg8::EpiSwiglu, pg8::StaticOrder, true, true>(lds, g, S, E);
                } else if (st == 2 || st == 9 || st == 12) {
                    const int sub = st == 2 ? 0 : (st == 9 ? 1 : 2);
                    const bf16_t* A = st == 9 ? HY : (const bf16_t*)(p->ws + OFF_HID);
                    const bf16_t* Bt = st == 9 ? WMO : (st == 2 ? WFO : (const bf16_t*)(p->ws + OFF_WFO2));
                    const int K = st == 9 ? (is_ab ? 1024 : 2048) : 2816;
                    const bool split = Mrows == T_ALL;
                    const int Mg = split ? T_LAT : Mrows;
                    pg8::Gemm g{A, Bt, Mg, 1024, K}; pg8::StaticOrder S; S.init(Mg, 1024, G, bid());
                    pg8::EpiResid E{xlat, xctx, X, MOD + (size_t)l * 9 * 9216 + (3 * sub + 2) * 1024, st == 9 ? 1.0f : 0.5f};
                    pg8::gemm_phase<pg8::EpiResid, pg8::StaticOrder, false, true>(lds, g, S, E);
                    if (split) {
                        const int Kh = K >> 1;
                        pg8::Gemm g2{st == 9 ? (const bf16_t*)HY + (size_t)T_LAT * K : (const bf16_t*)(p->ws + OFF_HIDC), (const bf16_t*)(p->ws + (st == 9 ? (is_ab ? OFF_WMOS_AB : OFF_WMOS_RET) : (st == 2 ? OFF_WFOS : OFF_WFOS2))), 4096, 2048, Kh}; pg8::CtxSplitOrder S2{G, bid()};
                        pg8::EpiPartial E2{(float*)(p->ws + OFF_PART)};
                        pg8::gemm_phase<pg8::EpiPartial, pg8::CtxSplitOrder, false, true>(lds, g2, S2, E2);
                    }
                    if (st == 2 || (st == 12 && !last)) {
                        const int first_idle = 64 % G, vb = bid() - first_idle;
                        if (vb >= 0) { const int gw2 = vb * 8 + wave, NGW2 = (G - first_idle) * 8; int rot = 0;
                            if (st == 2) {
                                convert_weights<1>(p->ffn_w_in + (size_t)(l * 2 + 1) * 1024 * 5632, 1024, 5632, (bf16_t*)(p->ws + OFF_WFI2), scr, gw2, NGW2, rot);
                                convert_weights<0>(p->ffn_w_out + (size_t)(l * 2 + 1) * 2816 * 1024, 2816, 1024, (bf16_t*)(p->ws + OFF_WFO2), scr, gw2, NGW2, rot, 1408, (bf16_t*)(p->ws + OFF_WFOS2));
                                if (is_ab) convert_weights<0>(p->ab_w_out + (size_t)mi * 1024 * 1024, 1024, 1024, WMO, scr, gw2, NGW2, rot, 512, (bf16_t*)(p->ws + OFF_WMOS_AB));
                                else convert_weights<0>(p->ret_w_out + (size_t)mi * 2048 * 1024, 2048, 1024, WMO, scr, gw2, NGW2, rot, 1024, last ? (bf16_t*)nullptr : (bf16_t*)(p->ws + OFF_WMOS_RET));
                            } else {
                                convert_weights<1>(p->ffn_w_in + (size_t)(l * 2 + 2) * 1024 * 5632, 1024, 5632, WFI, scr, gw2, NGW2, rot);
                                convert_weights<0>(p->ffn_w_out + (size_t)(l * 2 + 2) * 2816 * 1024, 2816, 1024, WFO, scr, gw2, NGW2, rot, 1408, (bf16_t*)(p->ws + OFF_WFOS));
                                if (!is_ab) convert_weights<2>(p->ab_w_in + (size_t)(mi + 1) * 1024 * 3600, 1024, 3600, WMI, scr, gw2, NGW2, rot);
                                else convert_weights<0>(p->ret_w_in + (size_t)mi * 1024 * 6144, 1024, 6144, WMI, scr, gw2, NGW2, rot);
                            } } }
                } else if (st == 4) {
                    const int N = is_ab ? 3840 : 6144;
                    pg8::Gemm g{HY, WMI, T_ALL, N, 1024}; pg8::StaticOrder S; S.init(T_ALL, N, G, bid());
                    pg8::EpiBf16 E{(bf16_t*)(p->ws + OFF_BIG), is_ab ? 3840 : 2048, is_ab ? 0 : 2048, is_ab ? (size_t)0 : RP_STRIDE};
                    pg8::gemm_phase<pg8::EpiBf16, pg8::StaticOrder, true, true>(lds, g, S, E);
                } else if (st == 5) {
                    PROBE_LOOP(PROBE_ST5) { if (is_ab) phase_ab_prep(p, mi, smem); else phase_ret_prep(p, mi, smem); }
                } else if (st == 6) {
                    PROBE_LOOP(PROBE_ST6) { if (is_ab) { const int extra = 576 % G;
                        phase_attn(p, mi, l, 576, smem); (void)extra; phase_dn_chunkprep(p, smem, bid(), G); }     else phase_ret_chunk(p, mi, smem, last); }
                } else if (st == 7) {
                    PROBE_LOOP(PROBE_ST7) { if (is_ab) phase_dn_chunkrec(p, smem); else phase_ret_merge(p, last ? T_LAT : T_ALL, gw, NGW); }
                } else if (st == 8) {
                    PROBE_LOOP(PROBE_ST8) { phase_dn_merge(p, mi, T_ALL, gw, NGW); }
                }
#ifdef DUP_MASK
              }
#endif
            }
            END_PHASE;
        }
        if (!is_ab) { ++ph; }
    }
    if (RUN_PHASE) { PrmC p = get_prm(); PHASE_LOCALS phase_final(p, gw, NGW); }
}

extern "C" void kernel_launch(void* const* d_in, const int* in_sizes, int n_in, void* d_out, int out_size, void* d_ws, size_t ws_size, hipStream_t stream) {
    static int grid_blocks = 0;
    if (grid_blocks == 0) {
        if (ws_size < WS_NEED) { fprintf(stderr, "kernel_launch: workspace too small: %zu < %zu\n", ws_size, (size_t)WS_NEED); grid_blocks = -1; return; }
        int dev = 0, cus = 0, per_cu = 0;
        hipGetDevice(&dev);
        hipDeviceGetAttribute(&cus, hipDeviceAttributeMultiprocessorCount, dev);
        if (hipFuncSetAttribute((const void*)fwd_megakernel, hipFuncAttributeMaxDynamicSharedMemorySize, LDS_BYTES) != hipSuccess) { fprintf(stderr, "kernel_launch: hipFuncSetAttribute failed\n"); grid_blocks = -1; return; }
        if (hipOccupancyMaxActiveBlocksPerMultiprocessor(&per_cu, (const void*)fwd_megakernel, NTHR, LDS_BYTES) != hipSuccess || per_cu < 1) { fprintf(stderr, "kernel_launch: occupancy query says %d\n", per_cu); per_cu = 1; (void)hipGetLastError(); }
        grid_blocks = cus * 1;
    }
    if (grid_blocks < 0) return;
    Prm p{};
    const float** pp = (const float**)&p;
    for (int i = 0; i < 21; ++i) pp[i] = (const float*)d_in[i];
    p.out = (float*)d_out; p.ws = (unsigned char*)d_ws;
    if (hipMemsetAsync((unsigned char*)d_ws + OFF_BAR, 0, SZ_BAR, stream) != hipSuccess) { fprintf(stderr, "kernel_launch: memset failed\n"); return; }
#if defined(MK_MULTI)
    for (int i = 0; i < N_PHASES; ++i) hipLaunchKernelGGL(fwd_megakernel, dim3(grid_blocks), dim3(NTHR), LDS_BYTES, stream, p, i, i + 1);
#else
    int lo = 0, hi = N_PHASES;
    void* args[] = {&p, &lo, &hi};
    hipError_t e = hipLaunchCooperativeKernel((const void*)fwd_megakernel, dim3(grid_blocks), dim3(NTHR), args, LDS_BYTES, stream);
    if (e != hipSuccess) fprintf(stderr, "cooperative launch failed: %s (grid %d)\n", hipGetErrorString(e), grid_blocks);
#endif
}
```

```cpp
#include <hip/hip_runtime.h>
#include <hip/hip_cooperative_groups.h>
#include <cstdio>
#include <cstdint>
namespace cg = cooperative_groups;

__device__ __forceinline__ int opaque_tid() { int t = threadIdx.x; asm volatile("" : "+v"(t)); return t; }
__device__ __forceinline__ int bid() { int b = blockIdx.x; asm volatile("" : "+s"(b)); return b; }
__device__ __forceinline__ int gdim() { int g = gridDim.x; asm volatile("" : "+s"(g)); return g; }
namespace pg8 {
#define PG8_LAS __attribute__((address_space(3)))
typedef unsigned short bf16_t;
typedef short bf16x8 __attribute__((ext_vector_type(8)));
typedef float f32x4 __attribute__((ext_vector_type(4)));
typedef unsigned u32x4 __attribute__((ext_vector_type(4)));
constexpr int BM = 256, BK = 64, HALF = 128, HTB = HALF * BK * 2  , STAGE_BYTES = 8 * HTB, NXCD = 8, WGM = 4;
__host__ __device__ __forceinline__ int lds_byte(int r, int c) { const int st = (r >> 4) * 2 + (c >> 5), rr = r & 15, cc = c & 31, ob = rr * 64 + cc * 2; return st * 1024 + (ob ^ (((ob >> 9) & 1) << 5)); }
__host__ __device__ __forceinline__ void stage_rc(int b, int& R, int& C) { const int st = b / 1024, sb = b % 1024, swz = sb ^ (((sb >> 9) & 1) << 5); R = (st >> 1) * 16 + swz / 64; C = (st & 1) * 32 + (swz % 64) / 2; }
__host__ __device__ __forceinline__ int perm32(int rho) { const int n = rho >> 4, i = rho & 15; return 8 * (i >> 2) + 4 * n + (i & 3); }

struct Unit { int pm, pn; };
struct Gemm { const bf16_t* A; const bf16_t* Bt; int M, N, K; };

struct StaticOrder {
    int nM, nN, nwg, G, c;
    __host__ __device__ void init(int M, int N, int G_, int c_) { nM = M / BM; nN = N / BM; nwg = nM * nN; G = G_; c = c_; }
    __host__ __device__ bool next(int i, Unit& u) const {
        const long L = (long)i * G + c; if (L >= nwg) return false;
        int wgid = (int)L; { const int q = nwg / NXCD, r = nwg % NXCD, xcd = wgid % NXCD, off = wgid / NXCD; wgid = (xcd < r ? xcd * (q + 1) : r * (q + 1) + (xcd - r) * q) + off; }
        const int nig = WGM * nN, gid = wgid / nig, fm = gid * WGM, gsz = (nM - fm) < WGM ? (nM - fm) : WGM;
        u.pm = fm + ((wgid % nig) % gsz); u.pn = (wgid % nig) / gsz; return true;
    }
    __device__ __forceinline__ void a_ready(const Unit&) const {}
    __device__ __forceinline__ void done(const Unit&) const {}
};

__device__ __forceinline__ unsigned cvt_pk_bf16(float lo, float hi) { unsigned r; asm volatile("v_cvt_pk_bf16_f32 %0, %1, %2" : "=v"(r) : "v"(lo), "v"(hi)); return r; }

__device__ __forceinline__ float fast_silu(float g) { return g * __builtin_amdgcn_rcpf(1.0f + __expf(-g)); }

struct EpiSwiglu {
    static constexpr bool PERM = true, AFTER_DRAIN = false;
    bf16_t* O; int ldc; bf16_t* OC;
    __device__ __forceinline__ void operator()(const f32x4 (&acc)[2][2][4][2], const Unit& u, int wr, int wc, int fr, int fq) const {
        const int row0 = u.pm * BM + wr * 64 + fr, col0 = u.pn * HALF + wc * 32 + 8 * fq;
        bf16_t* base = O + (size_t)row0 * ldc + col0; size_t pitch = (size_t)ldc;
        if (OC && u.pm >= 64) { const int kh = col0 >= 1408 ? 1 : 0; base = OC + ((size_t)kh * 2048 + (row0 - 16384)) * 1408 + (col0 - kh * 1408); pitch = 1408; }
#pragma unroll
        for (int ai = 0; ai < 2; ++ai)
#pragma unroll
            for (int m = 0; m < 4; ++m) { bf16_t* rowp = base + (size_t)(ai * HALF + m * 16) * pitch;
                const f32x4 g0 = acc[ai][0][m][0], g1 = acc[ai][0][m][1], u0 = acc[ai][1][m][0], u1 = acc[ai][1][m][1];
                float h[8];
#pragma unroll
                for (int j = 0; j < 4; ++j) { h[j] = fast_silu(g0[j]) * u0[j]; h[4 + j] = fast_silu(g1[j]) * u1[j]; }
                u32x4 w; w.x = cvt_pk_bf16(h[0], h[1]); w.y = cvt_pk_bf16(h[2], h[3]); w.z = cvt_pk_bf16(h[4], h[5]); w.w = cvt_pk_bf16(h[6], h[7]);
                *(u32x4*)rowp = w; }
    }
};
struct CtxSplitOrder {
    int G, c;
    __device__ bool next(int i, Unit& u) const { const int L = i * G + c; if (L >= 64) return false; const int kh = L >> 5, r = L & 31; u.pm = kh * 8 + (r >> 2); u.pn = kh * 4 + (r & 3); return true; }
    __device__ __forceinline__ void a_ready(const Unit&) const {}
    __device__ __forceinline__ void done(const Unit&) const {}
};
struct EpiPartial {
    static constexpr bool PERM = false, AFTER_DRAIN = false;
    float* P;
    __device__ __forceinline__ void operator()(const f32x4 (&acc)[2][2][4][2], const Unit& u, int wr, int wc, int fr, int fq) const {
        const int kh = u.pn >> 2, row0 = (u.pm & 7) * BM + wr * 64 + fr, col0 = (u.pn & 3) * BM + wc * 32 + 4 * fq;
        float* base = P + ((size_t)kh * 2048 + row0) * 1024 + col0;
#pragma unroll
        for (int ai = 0; ai < 2; ++ai)
#pragma unroll
            for (int m = 0; m < 4; ++m)
#pragma unroll
                for (int bj = 0; bj < 2; ++bj)
#pragma unroll
                    for (int n = 0; n < 2; ++n) *(f32x4*)(base + (size_t)(ai * HALF + m * 16) * 1024 + bj * HALF + n * 16) = acc[ai][bj][m][n];
    }
};
struct EpiResid {
    static constexpr bool PERM = false, AFTER_DRAIN = false;
    const float* xin_lat; const float* xin_ctx; float* xout; const float* gate; float s;
    __device__ __forceinline__ void operator()(const f32x4 (&acc)[2][2][4][2], const Unit& u, int wr, int wc, int fr, int fq) const {
        const int row0 = u.pm * BM + wr * 64 + fr, col0 = u.pn * BM + wc * 32 + 4 * fq;
        const int mr = u.pm < 64 ? (u.pm >> 3) : 8;
        f32x4 gv[2][2];
#pragma unroll
        for (int bj = 0; bj < 2; ++bj)
#pragma unroll
            for (int n = 0; n < 2; ++n) gv[bj][n] = *(const f32x4*)(gate + (size_t)mr * 9216 + col0 + bj * HALF + n * 16) * s;
#pragma unroll
        for (int ai = 0; ai < 2; ++ai) {
            f32x4 xv[4][2][2];
#pragma unroll
            for (int m = 0; m < 4; ++m) { const int row = row0 + ai * HALF + m * 16;
                const float* xi = row < 16384 ? xin_lat + (size_t)row * 1024 : xin_ctx + (size_t)(row - 16384) * 1024;
#pragma unroll
                for (int bj = 0; bj < 2; ++bj)
#pragma unroll
                    for (int n = 0; n < 2; ++n) xv[m][bj][n] = *(const f32x4*)(xi + col0 + bj * HALF + n * 16); }
            asm volatile("" ::: "memory");
#pragma unroll
            for (int m = 0; m < 4; ++m) { float* xo = xout + (size_t)(row0 + ai * HALF + m * 16) * 1024;
#pragma unroll
                for (int bj = 0; bj < 2; ++bj)
#pragma unroll
                    for (int n = 0; n < 2; ++n) *(f32x4*)(xo + col0 + bj * HALF + n * 16) = xv[m][bj][n] + gv[bj][n] * acc[ai][bj][m][n]; }
            asm volatile("" ::: "memory");
        }
    }
};
struct EpiBf16 {
    static constexpr bool PERM = true, AFTER_DRAIN = false;
    bf16_t* O; int ldc; int split_cols; size_t split_stride;
    __device__ __forceinline__ void operator()(const f32x4 (&acc)[2][2][4][2], const Unit& u, int wr, int wc, int fr, int fq) const {
        const int row0 = u.pm * BM + wr * 64 + fr; int colt = u.pn * BM; bf16_t* base = O;
        if (split_cols) { const int t = colt / split_cols; base += (size_t)t * split_stride; colt -= t * split_cols; }
        const int col0 = colt + wc * 32 + 8 * fq;
#pragma unroll
        for (int ai = 0; ai < 2; ++ai)
#pragma unroll
            for (int m = 0; m < 4; ++m) { bf16_t* rowp = base + (size_t)(row0 + ai * HALF + m * 16) * ldc + col0;
#pragma unroll
                for (int bj = 0; bj < 2; ++bj) { const f32x4 v0 = acc[ai][bj][m][0], v1 = acc[ai][bj][m][1];
                    u32x4 w; w.x = cvt_pk_bf16(v0[0], v0[1]); w.y = cvt_pk_bf16(v0[2], v0[3]); w.z = cvt_pk_bf16(v1[0], v1[1]); w.w = cvt_pk_bf16(v1[2], v1[3]);
                    *(u32x4*)(rowp + bj * HALF) = w; } }
    }
};

typedef PG8_LAS unsigned char* pg8_lds_t_;
template <class Epi, class Sched, bool ALIGN_EPI = false, bool SP2 = false>
__device__ __forceinline__ void gemm_phase(PG8_LAS unsigned char* lds, const Gemm g, const Sched& S, const Epi& E) {
    const int tid = opaque_tid(), wid = __builtin_amdgcn_readfirstlane(tid >> 6), lane = tid & 63, wr = wid >> 2, wc = wid & 3, fr = lane & 15, fq = lane >> 4;
    const int K = g.K, nt = K / BK;
    unsigned voffA[2], voffB[2];
#pragma unroll
    for (int i = 0; i < 2; ++i) { int R, C; stage_rc(tid * 16 + i * 8192, R, C); const int Rb = Epi::PERM ? ((R & ~31) + perm32(R & 31)) : R;
        voffA[i] = (unsigned)(R * K + C) * 2u; voffB[i] = (unsigned)(Rb * K + C) * 2u; }
    const size_t kstep = (size_t)(BK * 2);
    const size_t hstep = (size_t)HALF * K * 2;
    const size_t tstep = 2 * hstep;
    const unsigned ldsw = (unsigned)wid * 1024u;
    const int aoff = lds_byte(wr * 64 + fr, fq * 8), boff = lds_byte(wc * 32 + fr, fq * 8);
#define PG8_SA(b, h) (((b) * 2 + (h)) * HTB)
#define PG8_SB(b, h) ((4 + (b) * 2 + (h)) * HTB)
#define PG8_STAGE(bufoff, gbase, voff) do { _Pragma("unroll") for (int _i = 0; _i < 2; ++_i) \
        __builtin_amdgcn_global_load_lds((const unsigned*)((const char*)(gbase) + (voff)[_i]), (PG8_LAS unsigned*)(lds + (bufoff) + ldsw + _i * 8192), 16, 0, 0); } while (0)
#define PG8_LDA(dst, b, h) do { _Pragma("unroll") for (int m = 0; m < 4; ++m) _Pragma("unroll") for (int k = 0; k < 2; ++k) dst[m][k] = *(const PG8_LAS bf16x8*)(lds + PG8_SA(b, h) + aoff + m * 2048 + k * 1024); } while (0)
#define PG8_LDB(dst, b, h) do { _Pragma("unroll") for (int n = 0; n < 2; ++n) _Pragma("unroll") for (int k = 0; k < 2; ++k) dst[n][k] = *(const PG8_LAS bf16x8*)(lds + PG8_SB(b, h) + boff + n * 2048 + k * 1024); } while (0)
#define PG8_MMA(ai, bj, At, Bt) do { __builtin_amdgcn_s_setprio(1); _Pragma("unroll") for (int m = 0; m < 4; ++m) _Pragma("unroll") for (int n = 0; n < 2; ++n) _Pragma("unroll") for (int k = 0; k < 2; ++k) \
        acc[ai][bj][m][n] = __builtin_amdgcn_mfma_f32_16x16x32_bf16(Bt[n][k], At[m][k], acc[ai][bj][m][n], 0, 0, 0); __builtin_amdgcn_s_setprio(0); } while (0)
#define PG8_WAIT_V(n) asm volatile("s_waitcnt vmcnt(" #n ")" ::: "memory")
#define PG8_WAIT_L(n) asm volatile("s_waitcnt lgkmcnt(" #n ")" ::: "memory")
#define PG8_BAR __builtin_amdgcn_s_barrier()
#define PG8_SCHED __builtin_amdgcn_sched_barrier(0)
    Unit cur, nxt; int ui = 0;
    if (!S.next(0, cur)) return;
    f32x4 acc[2][2][4][2];
#pragma unroll
    for (int a = 0; a < 2; ++a)
#pragma unroll
        for (int b = 0; b < 2; ++b)
#pragma unroll
            for (int m = 0; m < 4; ++m)
#pragma unroll
                for (int n = 0; n < 2; ++n) acc[a][b][m][n] = (f32x4){0.f, 0.f, 0.f, 0.f};
    bf16x8 At[4][2], B0[2][2], B1[2][2];
    const char* cA = (const char*)g.A + (size_t)cur.pm * tstep; const char* cB = (const char*)g.Bt + (size_t)cur.pn * tstep;
    S.a_ready(cur);
    if constexpr (SP2) {
        PG8_STAGE(PG8_SB(0, 0), cB, voffB); PG8_STAGE(PG8_SB(0, 1), cB + hstep, voffB); PG8_STAGE(PG8_SA(0, 0), cA, voffA); PG8_STAGE(PG8_SA(0, 1), cA + hstep, voffA);
        if (wr == 1) PG8_BAR;
        PG8_WAIT_V(2); PG8_BAR;
        PG8_STAGE(PG8_SB(1, 0), cB + kstep, voffB); PG8_STAGE(PG8_SA(1, 0), cA + kstep, voffA); PG8_STAGE(PG8_SB(1, 1), cB + hstep + kstep, voffB);
        PG8_WAIT_V(6); PG8_BAR;
    } else {
        PG8_STAGE(PG8_SB(0, 0), cB, voffB); PG8_STAGE(PG8_SA(0, 0), cA, voffA); PG8_STAGE(PG8_SB(0, 1), cB + hstep, voffB); PG8_STAGE(PG8_SA(0, 1), cA + hstep, voffA);
        if (wr == 1) PG8_BAR;
        PG8_WAIT_V(4); PG8_BAR;
        PG8_STAGE(PG8_SB(1, 0), cB + kstep, voffB); PG8_STAGE(PG8_SA(1, 0), cA + kstep, voffA); PG8_STAGE(PG8_SB(1, 1), cB + hstep + kstep, voffB);
        PG8_WAIT_V(6); PG8_BAR;
    }
    for (;;) {
        const bool has_next = S.next(ui + 1, nxt);
        const char* nA = has_next ? (const char*)g.A + (size_t)nxt.pm * tstep : cA; const char* nB = has_next ? (const char*)g.Bt + (size_t)nxt.pn * tstep : cB;
        for (int t = 0; t < nt; t += 2) {
            const bool last = (t == nt - 2);
            const char* a1 = cA + (size_t)(t + 1) * kstep;
            const char* a2 = last ? nA : cA + (size_t)(t + 2) * kstep; const char* b2 = last ? nB : cB + (size_t)(t + 2) * kstep;
            const char* a3 = a2 + kstep; const char* b3 = b2 + kstep;
            if (last && has_next) S.a_ready(nxt);
            if constexpr (SP2) {
            PG8_LDB(B0, 0, 0); PG8_LDB(B1, 0, 1); PG8_SCHED; PG8_LDA(At, 0, 0); PG8_STAGE(PG8_SA(1, 1), a1 + hstep, voffA);
            PG8_WAIT_V(8); PG8_WAIT_L(0); PG8_BAR; PG8_MMA(0, 0, At, B0); PG8_MMA(0, 1, At, B1); PG8_BAR; PG8_SCHED;
            PG8_LDA(At, 0, 1); PG8_STAGE(PG8_SB(0, 0), b2, voffB); PG8_STAGE(PG8_SB(0, 1), b2 + hstep, voffB); PG8_STAGE(PG8_SA(0, 0), a2, voffA);
            PG8_WAIT_V(8); PG8_WAIT_L(0); PG8_BAR; PG8_MMA(1, 0, At, B0); PG8_MMA(1, 1, At, B1); PG8_BAR; PG8_SCHED;
            PG8_LDB(B0, 1, 0); PG8_LDB(B1, 1, 1); PG8_SCHED; PG8_LDA(At, 1, 0); PG8_STAGE(PG8_SA(0, 1), a2 + hstep, voffA);
            PG8_WAIT_V(8); PG8_WAIT_L(0); PG8_BAR; PG8_MMA(0, 0, At, B0); PG8_MMA(0, 1, At, B1); PG8_BAR; PG8_SCHED;
            PG8_LDA(At, 1, 1); PG8_STAGE(PG8_SB(1, 0), b3, voffB); PG8_STAGE(PG8_SB(1, 1), b3 + hstep, voffB); PG8_STAGE(PG8_SA(1, 0), a3, voffA);
            PG8_WAIT_V(8); PG8_WAIT_L(0); PG8_BAR; PG8_MMA(1, 0, At, B0); PG8_MMA(1, 1, At, B1); PG8_BAR; PG8_SCHED;
            } else {
            PG8_LDB(B0, 0, 0); PG8_SCHED; PG8_LDA(At, 0, 0); PG8_STAGE(PG8_SA(1, 1), a1 + hstep, voffA);
            PG8_WAIT_L(8); PG8_BAR; PG8_WAIT_L(0); PG8_MMA(0, 0, At, B0); PG8_BAR; PG8_SCHED;
            PG8_LDB(B1, 0, 1); PG8_STAGE(PG8_SB(0, 0), b2, voffB);
            PG8_BAR; PG8_WAIT_L(0); PG8_MMA(0, 1, At, B1); PG8_BAR;
            PG8_LDA(At, 0, 1); PG8_STAGE(PG8_SA(0, 0), a2, voffA);
            PG8_BAR; PG8_WAIT_L(0); PG8_MMA(1, 0, At, B0); PG8_BAR; PG8_SCHED;
            PG8_STAGE(PG8_SB(0, 1), b2 + hstep, voffB);
            PG8_WAIT_V(6); PG8_BAR; PG8_MMA(1, 1, At, B1); PG8_BAR;
            PG8_LDB(B0, 1, 0); PG8_SCHED; PG8_LDA(At, 1, 0); PG8_STAGE(PG8_SA(0, 1), a2 + hstep, voffA);
            PG8_WAIT_L(8); PG8_BAR; PG8_WAIT_L(0); PG8_MMA(0, 0, At, B0); PG8_BAR; PG8_SCHED;
            PG8_LDB(B1, 1, 1); PG8_STAGE(PG8_SB(1, 0), b3, voffB);
            PG8_BAR; PG8_WAIT_L(0); PG8_MMA(0, 1, At, B1); PG8_BAR;
            PG8_LDA(At, 1, 1); PG8_STAGE(PG8_SA(1, 0), a3, voffA);
            PG8_BAR; PG8_WAIT_L(0); PG8_MMA(1, 0, At, B0); PG8_BAR; PG8_SCHED;
            PG8_STAGE(PG8_SB(1, 1), b3 + hstep, voffB);
            PG8_WAIT_V(6); PG8_BAR; PG8_MMA(1, 1, At, B1); PG8_BAR;
            }
        }
        if constexpr (ALIGN_EPI) { if (wr == 0) PG8_BAR; }
        if constexpr (!Epi::AFTER_DRAIN) { E(acc, cur, wr, wc, fr, fq); S.done(cur); }
        if (!has_next) break;
#pragma unroll
        for (int a = 0; a < 2; ++a)
#pragma unroll
            for (int b = 0; b < 2; ++b)
#pragma unroll
                for (int m = 0; m < 4; ++m)
#pragma unroll
                    for (int n = 0; n < 2; ++n) acc[a][b][m][n] = (f32x4){0.f, 0.f, 0.f, 0.f};
        cur = nxt; cA = nA; cB = nB; ++ui;
        if constexpr (ALIGN_EPI) { if (wr == 1) PG8_BAR; }
    }
    PG8_WAIT_V(0);
    if constexpr (!ALIGN_EPI) { if (wr == 0) PG8_BAR; }
    PG8_BAR;
    if constexpr (Epi::AFTER_DRAIN) { E.fused(acc, cur, wr, wc, fr, fq, lds, wid, lane); S.done(cur); }
#undef PG8_SA
#undef PG8_SB
#undef PG8_STAGE
#undef PG8_LDA
#undef PG8_LDB
#undef PG8_MMA
#undef PG8_WAIT_V
#undef PG8_WAIT_L
#undef PG8_BAR
#undef PG8_SCHED
}
}
typedef pg8::pg8_lds_t_ pg8_lds_t;
using pg8::bf16_t; using pg8::bf16x8; using pg8::f32x4; using pg8::u32x4; using pg8::cvt_pk_bf16;
typedef float f32x16 __attribute__((ext_vector_type(16)));
#define MFMA32(a, b, c) __builtin_amdgcn_mfma_f32_32x32x16_bf16((a), (b), (c), 0, 0, 0)
typedef unsigned u32x2_t __attribute__((ext_vector_type(2)));
#define DI __device__ __forceinline__
#define LDS_WAIT() asm volatile("s_waitcnt lgkmcnt(0)" ::: "memory")

constexpr int NTHR = 512;
constexpr int T_LAT = 16384, T_ALL = 18432;
constexpr size_t SZ_MOD = (size_t)4 * 9 * 9216 * 4;
constexpr size_t OFF_BAR = 0;
constexpr size_t SZ_BAR = 16384;
constexpr size_t OFF_MOD = OFF_BAR + SZ_BAR;
constexpr size_t OFF_ROPE_RET = OFF_MOD + SZ_MOD;
constexpr size_t OFF_ROPE_AX = OFF_ROPE_RET + (size_t)2048 * 64 * 8;
constexpr size_t OFF_X   = OFF_ROPE_AX + (size_t)64 * 16 * 8;
constexpr size_t OFF_HY  = OFF_X + (size_t)T_ALL * 1024 * 4;
constexpr size_t OFF_WFI = OFF_HY + (size_t)T_ALL * 2048 * 2;
constexpr size_t OFF_WFO = OFF_WFI + (size_t)5632 * 1024 * 2;
constexpr size_t OFF_WMI = OFF_WFO + (size_t)1024 * 2816 * 2;
constexpr size_t OFF_WMO = OFF_WMI + (size_t)6144 * 1024 * 2;
constexpr size_t OFF_WFI2 = OFF_WMO + (size_t)1024 * 2048 * 2;
constexpr size_t OFF_WFO2 = OFF_WFI2 + (size_t)5632 * 1024 * 2;
constexpr size_t OFF_WFOS  = OFF_WFO2 + (size_t)1024 * 2816 * 2;
constexpr size_t OFF_WFOS2 = OFF_WFOS + (size_t)2 * 1024 * 1408 * 2;
constexpr size_t OFF_BIG = OFF_WFOS2 + (size_t)2 * 1024 * 1408 * 2;
constexpr size_t OFF_HID = OFF_BIG;
constexpr size_t OFF_HIDC = OFF_BIG + (size_t)T_ALL * 2816 * 2;
constexpr size_t OFF_PART = OFF_HIDC + (size_t)2 * 2048 * 1408 * 2;
constexpr size_t OFF_ABP = OFF_BIG;
constexpr size_t OFF_QN  = OFF_ABP + (size_t)T_ALL * 3840 * 2;
constexpr size_t OFF_KN  = OFF_QN + (size_t)T_ALL * 512 * 4;
constexpr size_t OFF_VN  = OFF_KN + (size_t)T_ALL * 512 * 4;
constexpr size_t OFF_LA  = OFF_VN + (size_t)T_ALL * 512 * 4;
constexpr size_t OFF_BE  = OFF_LA + (size_t)T_ALL * 8 * 4;
constexpr size_t OFF_ODN = OFF_QN;
constexpr size_t OFF_QD  = OFF_BE + (size_t)T_ALL * 8 * 4;
constexpr size_t OFF_KD  = OFF_QD + (size_t)32 * 2304 * 128 * 2;
constexpr size_t OFF_VT  = OFF_KD + (size_t)32 * 2304 * 128 * 2;
constexpr size_t OFF_DW  = OFF_VT + (size_t)32 * 2304 * 128 * 2;
constexpr size_t OFF_DQE = OFF_DW + (size_t)2 * 1152 * 64 * 128 * 2;
constexpr size_t OFF_DKT = OFF_DQE + (size_t)2 * 1152 * 64 * 128 * 2;
constexpr size_t OFF_DQK = OFF_DKT + (size_t)2 * 1152 * 128 * 64 * 2;
constexpr size_t OFF_DUT = OFF_DQK + (size_t)2 * 1152 * 64 * 64 * 2;
constexpr size_t OFF_DEG = OFF_DUT + (size_t)2 * 1152 * 128 * 64 * 4;
constexpr size_t END_AB  = OFF_DEG + (size_t)2 * 1152 * 4 + 256;
constexpr size_t OFF_RP  = OFF_BIG;
constexpr size_t RP_STRIDE = (size_t)T_ALL * 2048;
constexpr size_t OFF_QR  = OFF_RP + 3 * RP_STRIDE * 2;
constexpr size_t OFF_KR  = OFF_QR + (size_t)T_ALL * 1024 * 2;
constexpr size_t OFF_KDT = OFF_KR + (size_t)T_ALL * 1024 * 2;
constexpr size_t OFF_VTR = OFF_KDT + (size_t)2 * 288 * 8 * 128 * 64 * 2;
constexpr size_t OFF_OR  = OFF_RP;
constexpr size_t END_RET = OFF_VTR + (size_t)288 * 8 * 256 * 64 * 2;
constexpr size_t OFF_WMOS_AB = OFF_HY + (size_t)T_ALL * 1024 * 2;
constexpr size_t OFF_WMOS_RET = END_RET;
constexpr size_t WS_NEED = (END_RET + (size_t)1024 * 2048 * 2) > END_AB ? (END_RET + (size_t)1024 * 2048 * 2) : END_AB;

struct Prm {
    const float *x, *c, *ctx, *c_ctx, *ada_w, *ada_b, *norm_w, *final_norm_w, *ffn_w_in, *ffn_w_out, *ab_w_in, *ab_conv_w, *dn_A_log, *dn_dt_bias,
        *dn_norm_w, *diff_lambda, *diff_subln_w, *ab_w_out, *ret_w_in, *ret_decay_logit, *ret_w_out;
    float* out; unsigned char* ws;
};

typedef const Prm __attribute__((address_space(4)))* PrmC;
DI PrmC get_prm() { auto k = __builtin_amdgcn_kernarg_segment_ptr(); asm volatile("" : "+s"(k)); return (PrmC)k; }
DI float bf2f(unsigned v) { return __uint_as_float(v << 16); }
DI unsigned f2bf(float f) { unsigned u = __float_as_uint(f); return (u + 0x7fffu + ((u >> 16) & 1u)) >> 16; }
DI unsigned pk2(float lo, float hi) { return f2bf(lo) | (f2bf(hi) << 16); }
DI void unpack8(const uint4 v, float* f) {
    f[0] = __uint_as_float(v.x << 16); f[1] = __uint_as_float(v.x & 0xffff0000u); f[2] = __uint_as_float(v.y << 16); f[3] = __uint_as_float(v.y & 0xffff0000u);
    f[4] = __uint_as_float(v.z << 16); f[5] = __uint_as_float(v.z & 0xffff0000u); f[6] = __uint_as_float(v.w << 16); f[7] = __uint_as_float(v.w & 0xffff0000u);
}
DI uint4 pack8(const float* f) { uint4 o; o.x = pk2(f[0], f[1]); o.y = pk2(f[2], f[3]); o.z = pk2(f[4], f[5]); o.w = pk2(f[6], f[7]); return o; }
template <int CTRL> DI float dpp_f(float v) { return __int_as_float(__builtin_amdgcn_update_dpp(0, __float_as_int(v), CTRL, 0xF, 0xF, true)); }
DI float sum4(float v)  { v += dpp_f<0xB1>(v); v += dpp_f<0x4E>(v); return v; }
DI float sum8(float v)  { v = sum4(v); v += dpp_f<0x141>(v); return v; }
DI float sum16(float v) { v = sum8(v); v += dpp_f<0x140>(v); return v; }
DI float wave_sum(float v) {
#pragma unroll
    for (int o = 1; o < 64; o <<= 1) v += __shfl_xor(v, o);
    return v;
}
DI float silu_f(float g) { return g / (1.0f + __expf(-g)); }

DI void phase_mod(PrmC p, unsigned char* smem) {
    float* s_sh = (float*)smem;
    unsigned redb_ = 9 * 1024 * 4; asm volatile("" : "+v"(redb_));
    __attribute__((address_space(3))) float* red = (__attribute__((address_space(3))) float*)(uintptr_t)redb_;
    float* MOD = (float*)(p->ws + OFF_MOD);
    const int tid = opaque_tid(), lane = tid & 63, ks = tid >> 6;
    { float2* RT = (float2*)(p->ws + OFF_ROPE_RET); float2* AX = (float2*)(p->ws + OFF_ROPE_AX);
      for (int i = bid() * NTHR + tid; i < 2048 * 64; i += gdim() * NTHR) { const float ang = (float)(i >> 6) * exp2f(-(float)(i & 63) * (13.287712379549449f / 63.0f)); RT[i] = make_float2(cosf(ang), sinf(ang)); }
      for (int i = bid() * NTHR + tid; i < 64 * 16; i += gdim() * NTHR) { const float ang = (float)(i >> 4) * exp2f(-(float)(i & 15) * (13.287712379549449f / 16.0f)); AX[i] = make_float2(cosf(ang), sinf(ang)); } }
    for (int i = tid; i < 9 * 1024; i += NTHR) { const int rr = i >> 10, kk = i & 1023; const float cv = rr < 8 ? p->c[rr * 1024 + kk] : p->c_ctx[kk]; s_sh[i] = silu_f(cv); }
    __syncthreads();
    for (int it = bid(); it < 144; it += gdim()) {
        const int l = it / 36, cb = it % 36, col = cb * 256 + lane * 4;
        const float* w = p->ada_w + ((size_t)l * 1024 + ks * 128) * 9216 + col;
        float acc[9][4];
#pragma unroll
        for (int a = 0; a < 9; ++a) { acc[a][0] = 0.f; acc[a][1] = 0.f; acc[a][2] = 0.f; acc[a][3] = 0.f; }
#pragma unroll 4
        for (int k = 0; k < 128; ++k) { const float4 wv = *(const float4*)(w + (size_t)k * 9216);
#pragma unroll
            for (int a = 0; a < 9; ++a) { const float sv = s_sh[a * 1024 + ks * 128 + k]; acc[a][0] += sv * wv.x; acc[a][1] += sv * wv.y; acc[a][2] += sv * wv.z; acc[a][3] += sv * wv.w; } }
#pragma unroll
        for (int a = 0; a < 9; ++a) *(float4*)(red + (ks * 9 + a) * 256 + lane * 4) = make_float4(acc[a][0], acc[a][1], acc[a][2], acc[a][3]);
        __syncthreads();
        for (int o = tid; o < 9 * 256; o += NTHR) { const int a = o >> 8, c = o & 255; float v = p->ada_b[l * 9216 + cb * 256 + c];
#pragma unroll
            for (int q = 0; q < 8; ++q) v += red[(q * 9 + a) * 256 + c];
            MOD[((size_t)l * 9 + a) * 9216 + cb * 256 + c] = v; }
        __syncthreads();
    }
}

template <int MODE> DI int dest_row(int n) {
    if (MODE == 0 || MODE == 3) return n;
    if (MODE == 1) { const int bj = n >= 2816 ? 1 : 0, r = n - bj * 2816; return 256 * (r >> 7) + 128 * bj + (r & 127); }
    return n < 2048 ? n : (n < 2064 ? 3584 + (n - 2048) : n - 16);
}
template <int MODE> DI void convert_weights(const float* W, int K, int N, bf16_t* WT, float* scr, int gw, int NGW, int& rot, int khalf = 1408, bf16_t* WT2 = nullptr) {
    const int lane = opaque_tid() & 63;
    const int nblk = (N + 63) >> 6, nitems = (K >> 6) * nblk;
    int first = gw - rot; if (first < 0) first += NGW;
    for (int item = first; item < nitems; item += NGW) {
        const int kb = item / nblk, nb = item - kb * nblk, k0 = kb << 6, n0 = nb << 6;
        const int nl = (lane & 15) * 4, kr = lane >> 4;
        const bool ok = n0 + nl < N;
        float4 v[16];
#pragma unroll
        for (int i = 0; i < 16; ++i) v[i] = ok ? *(const float4*)(W + (size_t)(k0 + 4 * i + kr) * N + n0 + nl) : make_float4(0.f, 0.f, 0.f, 0.f);
#pragma unroll
        for (int i = 0; i < 16; ++i) *(float4*)(scr + (4 * i + kr) * 68 + nl) = v[i];
        LDS_WAIT();
        const int nn = n0 + lane;
        if (nn < N) {
            bf16_t* dst = MODE == 3 ? WT + ((size_t)(k0 / khalf) * 1024 + nn) * khalf + (k0 % khalf) : WT + (size_t)dest_row<MODE>(nn) * K + k0;
            bf16_t* dst2 = WT2 ? WT2 + ((size_t)(k0 / khalf) * 1024 + nn) * khalf + (k0 % khalf) : nullptr;
#pragma unroll
            for (int kg = 0; kg < 8; ++kg) { const float* t = scr + (8 * kg) * 68 + lane;
                uint4 o; o.x = pk2(t[0 * 68], t[1 * 68]); o.y = pk2(t[2 * 68], t[3 * 68]); o.z = pk2(t[4 * 68], t[5 * 68]); o.w = pk2(t[6 * 68], t[7 * 68]);
                *(uint4*)(dst + 8 * kg) = o; if (WT2) *(uint4*)(dst2 + 8 * kg) = o; }
        }
        LDS_WAIT();
    }
    rot = (rot + nitems) % NGW;
}

DI void norm_rows(PrmC p, const float* xlat, const float* xctx, int l, int sub, int nrows, int gw, int NGW, int& rot, const float* fixgate, float fixs) {
    const int lane = opaque_tid() & 63;
    const float* MOD = (const float*)(p->ws + OFF_MOD);
    bf16_t* H = (bf16_t*)(p->ws + OFF_HY);
    const float* nw = p->norm_w + ((size_t)l * 3 + sub) * 1024;
    int first = gw - rot; if (first < 0) first += NGW;
    for (int row0 = first; row0 < nrows; row0 += 2 * NGW) {
        const int row1 = row0 + NGW; const bool has1 = row1 < nrows; const int r1 = has1 ? row1 : row0;
        const float* xa = row0 < T_LAT ? xlat + (size_t)row0 * 1024 : xctx + (size_t)(row0 - T_LAT) * 1024;
        const float* xb = r1 < T_LAT ? xlat + (size_t)r1 * 1024 : xctx + (size_t)(r1 - T_LAT) * 1024;
        float4 va[4], vb[4]; float sa = 0.f, sb = 0.f;
#pragma unroll
        for (int j = 0; j < 4; ++j) { va[j] = *(const float4*)(xa + j * 256 + lane * 4); vb[j] = *(const float4*)(xb + j * 256 + lane * 4); }
        if (fixgate) {
            const float* PART = (const float*)(p->ws + OFF_PART); float* X = (float*)(p->ws + OFF_X);
            if (row0 >= T_LAT) { const float* p0 = PART + (size_t)(row0 - T_LAT) * 1024; const float* p1 = p0 + (size_t)2048 * 1024;
#pragma unroll
                for (int j = 0; j < 4; ++j) { const int c = j * 256 + lane * 4; const float4 g = *(const float4*)(fixgate + c), a = *(const float4*)(p0 + c), b2 = *(const float4*)(p1 + c);
                    va[j].x += fixs * g.x * (a.x + b2.x); va[j].y += fixs * g.y * (a.y + b2.y); va[j].z += fixs * g.z * (a.z + b2.z); va[j].w += fixs * g.w * (a.w + b2.w);
                    *(float4*)(X + (size_t)row0 * 1024 + c) = va[j]; } }
            if (has1 && row1 >= T_LAT) { const float* p0 = PART + (size_t)(row1 - T_LAT) * 1024; const float* p1 = p0 + (size_t)2048 * 1024;
#pragma unroll
                for (int j = 0; j < 4; ++j) { const int c = j * 256 + lane * 4; const float4 g = *(const float4*)(fixgate + c), a = *(const float4*)(p0 + c), b2 = *(const float4*)(p1 + c);
                    vb[j].x += fixs * g.x * (a.x + b2.x); vb[j].y += fixs * g.y * (a.y + b2.y); vb[j].z += fixs * g.z * (a.z + b2.z); vb[j].w += fixs * g.w * (a.w + b2.w);
                    *(float4*)(X + (size_t)row1 * 1024 + c) = vb[j]; } }
        }
#pragma unroll
        for (int j = 0; j < 4; ++j) { sa += va[j].x * va[j].x + va[j].y * va[j].y + va[j].z * va[j].z + va[j].w * va[j].w; sb += vb[j].x * vb[j].x + vb[j].y * vb[j].y + vb[j].z * vb[j].z + vb[j].w * vb[j].w; }
#pragma unroll
        for (int o = 1; o < 64; o <<= 1) { sa += __shfl_xor(sa, o); sb += __shfl_xor(sb, o); }
        const float ra = rsqrtf(sa * (1.0f / 1024.0f) + 1e-6f), rb = rsqrtf(sb * (1.0f / 1024.0f) + 1e-6f);
        const float* mda = MOD + (((size_t)l * 9 + (row0 < T_LAT ? (row0 >> 11) : 8)) * 9 + 3 * sub) * 1024;
        const float* mdb = MOD + (((size_t)l * 9 + (r1 < T_LAT ? (r1 >> 11) : 8)) * 9 + 3 * sub) * 1024;
#pragma unroll
        for (int j = 0; j < 4; ++j) { const int c = j * 256 + lane * 4;
            const float4 w = *(const float4*)(nw + c);
            { const float4 sh = *(const float4*)(mda + c), sc = *(const float4*)(mda + 1024 + c);
              uint2 o; o.x = pk2(va[j].x * ra * w.x * (1.f + sc.x) + sh.x, va[j].y * ra * w.y * (1.f + sc.y) + sh.y); o.y = pk2(va[j].z * ra * w.z * (1.f + sc.z) + sh.z, va[j].w * ra * w.w * (1.f + sc.w) + sh.w);
              *(uint2*)(H + (size_t)row0 * 1024 + c) = o; }
            if (has1) { const float4 sh = *(const float4*)(mdb + c), sc = *(const float4*)(mdb + 1024 + c);
              uint2 o; o.x = pk2(vb[j].x * rb * w.x * (1.f + sc.x) + sh.x, vb[j].y * rb * w.y * (1.f + sc.y) + sh.y); o.y = pk2(vb[j].z * rb * w.z * (1.f + sc.z) + sh.z, vb[j].w * rb * w.w * (1.f + sc.w) + sh.w);
              *(uint2*)(H + (size_t)row1 * 1024 + c) = o; } }
    }
    rot = (rot + nrows) % NGW;
}

DI void phase_ab_prep(PrmC p, int ai, unsigned char* smem) {
    const bf16_t* P = (const bf16_t*)(p->ws + OFF_ABP);
    bf16_t* QN = (bf16_t*)(p->ws + OFF_QN); bf16_t* KN = (bf16_t*)(p->ws + OFF_KN); float* VN = (float*)(p->ws + OFF_VN);
    float* LA = (float*)(p->ws + OFF_LA); float* BE = (float*)(p->ws + OFF_BE);
    bf16_t* QD = (bf16_t*)(p->ws + OFF_QD); bf16_t* KD = (bf16_t*)(p->ws + OFF_KD); bf16_t* VT = (bf16_t*)(p->ws + OFF_VT);
    const float* cw = p->ab_conv_w + (size_t)ai * 3 * 1536;
    bf16_t* vt_l = (bf16_t*)smem;
    const int tid = opaque_tid(), lane = tid & 63, wave = tid >> 6;
    for (int item = bid(); item < T_ALL / 16; item += gdim()) {
        const int r0 = item * 16; const bool lat = r0 < T_LAT;
        const int b = lat ? (r0 >> 11) : ((r0 - T_LAT) >> 8), t0 = lat ? (r0 & 2047) : ((r0 - T_LAT) & 255), Ls = lat ? 2048 : 256, key0 = lat ? 256 + t0 : t0;
        __syncthreads();
        for (int idx = tid; idx < 1024; idx += NTHR) { const int rr = idx >> 6, seg = idx & 63;
            *(uint4*)(vt_l + rr * 520 + seg * 8) = *(const uint4*)(P + (size_t)(r0 + rr) * 3840 + 3072 + seg * 8); }
        __syncthreads();
        { const int hh = tid >> 7, dv = tid & 127; unsigned w[8];
#pragma unroll
            for (int k = 0; k < 8; ++k) w[k] = (unsigned)vt_l[(2 * k) * 520 + tid] | ((unsigned)vt_l[(2 * k + 1) * 520 + tid] << 16);
            bf16_t* dst = VT + ((size_t)((b * 4 + hh) * 128 + dv)) * 2304 + key0;
            *(uint4*)dst = make_uint4(w[0], w[1], w[2], w[3]); *(uint4*)(dst + 8) = make_uint4(w[4], w[5], w[6], w[7]); }
#pragma unroll
        for (int tt = 0; tt < 2; ++tt) {
            const int row = r0 + 2 * wave + tt, ti = t0 + 2 * wave + tt;
            const bf16_t* pr = P + (size_t)row * 3840;
            float res[3][8];
#pragma unroll
            for (int sec = 0; sec < 3; ++sec) {
                const int ch = sec * 512 + lane * 8;
                float acc[8];
#pragma unroll
                for (int e = 0; e < 8; ++e) acc[e] = 0.f;
#pragma unroll
                for (int tap = 0; tap < 3; ++tap) {
                    const int tn = ti + tap - 1;
                    if (tn >= 0 && tn < Ls) {
                        float u[8]; unpack8(*(const uint4*)(pr + (ptrdiff_t)(tap - 1) * 3840 + ch), u);
                        const float4 w0 = *(const float4*)(cw + tap * 1536 + ch), w1 = *(const float4*)(cw + tap * 1536 + ch + 4);
                        acc[0] += w0.x * u[0]; acc[1] += w0.y * u[1]; acc[2] += w0.z * u[2]; acc[3] += w0.w * u[3];
                        acc[4] += w1.x * u[4]; acc[5] += w1.y * u[5]; acc[6] += w1.z * u[6]; acc[7] += w1.w * u[7];
                    }
                }
#pragma unroll
                for (int e = 0; e < 8; ++e) res[sec][e] = silu_f(acc[e]);
            }
            { float sq = 0.f, sk = 0.f;
#pragma unroll
              for (int e = 0; e < 8; ++e) { sq += res[0][e] * res[0][e]; sk += res[1][e] * res[1][e]; }
              sq = sum16(sq); sk = sum16(sk);
              const float rq = rsqrtf(sq + 1e-6f) * 0.08838834764831845f, rk = rsqrtf(sk + 1e-6f);
              float* vo = VN + (size_t)row * 512 + lane * 8;
              float qs8[8], ks8[8];
#pragma unroll
              for (int e = 0; e < 8; ++e) { qs8[e] = res[0][e] * rq; ks8[e] = res[1][e] * rk; }
              *(uint4*)(QN + (size_t)row * 512 + lane * 8) = pack8(qs8); *(uint4*)(KN + (size_t)row * 512 + lane * 8) = pack8(ks8);
              *(float4*)vo = make_float4(res[2][0], res[2][1], res[2][2], res[2][3]); *(float4*)(vo + 4) = make_float4(res[2][4], res[2][5], res[2][6], res[2][7]); }
            if (lane < 8) { const float a = bf2f(pr[3584 + lane]) + p->dn_dt_bias[ai * 8 + lane];
                const float sp = a > 20.f ? a : log1pf(__expf(a));
                LA[(size_t)row * 8 + lane] = -__expf(p->dn_A_log[ai * 8 + lane]) * sp; }
            else if (lane < 16) { const float bb = bf2f(pr[3592 + lane - 8]); BE[(size_t)row * 8 + lane - 8] = 1.0f / (1.0f + __expf(-bb)); }
            { float q[8], k[8]; unpack8(*(const uint4*)(pr + 2048 + lane * 8), q); unpack8(*(const uint4*)(pr + 2560 + lane * 8), k);
              const int hh = lane >> 4, cc = (lane & 15) * 8, d0 = cc & 63;
              if (lat) {
                  const int o = d0 & 31; const int ipos = (d0 & 32) ? (ti & 63) : (ti >> 6); const bool firsth = o < 16;
                  const float2* ax = (const float2*)(p->ws + OFF_ROPE_AX) + ipos * 16 + (o & 15);
#pragma unroll
                  for (int e = 0; e < 8; ++e) {
                      const float qp = __shfl_xor(q[e], 2), kp = __shfl_xor(k[e], 2);
                      const float2 cs2 = ax[e];
                      q[e] = q[e] * cs2.x + (firsth ? -qp : qp) * cs2.y; k[e] = k[e] * cs2.x + (firsth ? -kp : kp) * cs2.y;
                  }
              }
              const float qs = 0.125f * 1.4426950408889634f;
#pragma unroll
              for (int e = 0; e < 8; ++e) q[e] *= qs;
              const size_t off = ((size_t)(b * 4 + hh) * 2304 + key0 + 2 * wave + tt) * 128 + cc;
              *(uint4*)(QD + off) = pack8(q); *(uint4*)(KD + off) = pack8(k); }
        }
    }
}

DI int xcd_group_item(int blk, int G) { if (G != 256) return blk; const int x = blk & 7, k = blk >> 3; return ((x + 8 * (k >> 2)) << 2) + (k & 3); }
DI int seq_row(int b, int dir, int pos) {
    if (pos < 256) return T_LAT + b * 256 + (dir ? 255 - pos : pos);
    const int i = pos - 256; return b * 2048 + (dir ? 2047 - i : i);
}
typedef float __attribute__((address_space(3)))* lf_t;
typedef float __attribute__((address_space(3)))* lf_t;
template <int D> DI void dn_rhs(float (&x)[64], const float* VN, lf_t Kl, lf_t Gn, lf_t Bn, int row0, int h, int t) {
            asm volatile("" : "+v"(t));
            const lf_t Gd = Gn + D * 64, Bd = Bn + D * 64;
            if (t < 128) {
                unsigned voff = (unsigned)(((row0 + (D ? 63 : 0)) * 512 + h * 128 + t) * 4);
#pragma unroll
                for (int pi = 0; pi < 64; ++pi) { const int n = D ? 63 - pi : pi; x[pi] = *(const float*)((const char*)VN + voff) * Bd[n]; voff += D ? -2048 : 2048; asm volatile("" : "+v"(voff)); }
            } else {
#pragma unroll
                for (int pi = 0; pi < 64; ++pi) { const int n = D ? 63 - pi : pi; x[pi] = Kl[n * 132 + (t - 128)] * Bd[n] * __expf(Gd[n]); }
            }
}
DI void dn_solve_core(float (&x)[64], lf_t Ad) {
    float4 cur[16], nxt[16];
    cur[0] = *(const float4*)(Ad + 68);
#pragma unroll
    for (int pi = 1; pi < 64; ++pi) {
        if (pi + 1 < 64) {
#pragma unroll
            for (int g4 = 0; g4 < (pi + 4) / 4; ++g4) nxt[g4] = *(const float4*)(Ad + (pi + 1) * 68 + 4 * g4);
        }
        float a = x[pi], a2 = 0.f;
#pragma unroll
        for (int g4 = 0; g4 < (pi + 3) / 4; ++g4) { const float4 av = cur[g4];
            if (4 * g4 + 0 < pi) a -= av.x * x[4 * g4 + 0];
            if (4 * g4 + 1 < pi) a2 -= av.y * x[4 * g4 + 1];
            if (4 * g4 + 2 < pi) a -= av.z * x[4 * g4 + 2];
            if (4 * g4 + 3 < pi) a2 -= av.w * x[4 * g4 + 3]; }
        x[pi] = a + a2;
        asm volatile("" ::: "memory");
#pragma unroll
        for (int g4 = 0; g4 < (pi + 4) / 4; ++g4) cur[g4] = nxt[g4];
    }
}
template <int D> DI void dn_out(float (&x)[64], lf_t Kl, lf_t Ql, lf_t Gn, bf16_t* DW, bf16_t* DQE, bf16_t* DKT, bf16_t* DUT, float* DEG, int item, int t) {
            asm volatile("" : "+v"(t));
            const lf_t Gd = Gn + D * 64;
            if (t < 128) { bf16_t* uo = DUT + (((size_t)D * 1152 + item) * 128 + t) * 64;
#pragma unroll
                for (int g8 = 0; g8 < 8; ++g8) *(uint4*)(uo + 8 * g8) = pack8(x + 8 * g8);
            } else { bf16_t* wbase = DW + (((size_t)D * 1152 + item) * 64) * 128; unsigned woff = (unsigned)((t - 128) * 2);
#pragma unroll
                for (int pi = 0; pi < 64; ++pi) { *(bf16_t*)((char*)wbase + woff) = (bf16_t)f2bf(x[pi]); woff += 256; asm volatile("" : "+v"(woff)); } }
            const float glast = Gd[D ? 0 : 63];
#pragma unroll
            for (int i = 0; i < 4; ++i) { const int idx = t + 256 * i, pi = idx >> 4, seg = idx & 15, n = D ? 63 - pi : pi; const float e = __expf(Gd[n]);
                const float4 a0 = *(const float4*)(Ql + n * 132 + seg * 8), a1 = *(const float4*)(Ql + n * 132 + seg * 8 + 4);
                uint4 o; o.x = pk2(a0.x * e, a0.y * e); o.y = pk2(a0.z * e, a0.w * e); o.z = pk2(a1.x * e, a1.y * e); o.w = pk2(a1.z * e, a1.w * e);
                *(uint4*)(DQE + (((size_t)D * 1152 + item) * 64 + pi) * 128 + seg * 8) = o; }
#pragma unroll
            for (int i = 0; i < 4; ++i) { const int idx = t + 256 * i, dk = idx & 127, pg = idx >> 7; float v[8];
#pragma unroll
                for (int e = 0; e < 8; ++e) { const int pi = 8 * pg + e, n = D ? 63 - pi : pi; v[e] = Kl[n * 132 + dk] * __expf(glast - Gd[n]); }
                *(uint4*)(DKT + (((size_t)D * 1152 + item) * 128 + dk) * 64 + 8 * pg) = pack8(v); }
            if (t == 0) DEG[D * 1152 + item] = __expf(glast);
}

DI void phase_dn_chunkprep(PrmC p, unsigned char* smem, int vb, int nvb) {
    const bf16_t* QN = (const bf16_t*)(p->ws + OFF_QN); const bf16_t* KN = (const bf16_t*)(p->ws + OFF_KN); const float* VN = (const float*)(p->ws + OFF_VN);
    const float* LA = (const float*)(p->ws + OFF_LA); const float* BE = (const float*)(p->ws + OFF_BE);
    bf16_t* DW = (bf16_t*)(p->ws + OFF_DW); bf16_t* DQE = (bf16_t*)(p->ws + OFF_DQE); bf16_t* DKT = (bf16_t*)(p->ws + OFF_DKT); bf16_t* DQK = (bf16_t*)(p->ws + OFF_DQK);
    bf16_t* DUT = (bf16_t*)(p->ws + OFF_DUT); float* DEG = (float*)(p->ws + OFF_DEG);
    typedef float __attribute__((address_space(3)))* lf;
    unsigned bK_ = 0u, bQ_ = 64 * 132 * 4, bA_ = 2 * 64 * 132 * 4, bG_ = 2 * 64 * 132 * 4 + 2 * 64 * 68 * 4, bB_ = 2 * 64 * 132 * 4 + 2 * 64 * 68 * 4 + 1024;
    asm volatile("" : "+v"(bK_), "+v"(bQ_), "+v"(bA_), "+v"(bG_), "+v"(bB_));
    typedef __attribute__((address_space(3))) unsigned char* lb;
    const lb Kb = (lb)(uintptr_t)bB_, Qb = Kb + 64 * 272;
    const lf Kl = (lf)(uintptr_t)bK_, Ql = (lf)(uintptr_t)bQ_, Al = (lf)(uintptr_t)bA_, Gn = (lf)(uintptr_t)bG_, Bn = Gn + 128;
    (void)smem;
    const int tid = opaque_tid(), d = __builtin_amdgcn_readfirstlane(tid >> 8), t = tid & 255;
    for (int item = vb < 0 ? 1152 : vb; item < 1152; item += nvb) {
        const int cidx = item % 36, bh = item / 36, h = bh & 3, b = bh >> 2;
        const int row0 = cidx < 4 ? T_LAT + b * 256 + cidx * 64 : b * 2048 + (cidx - 4) * 64;
        __syncthreads();
#pragma unroll
        for (int i = 0; i < 2; ++i) { const int idx = tid + i * NTHR, n = idx >> 4, seg = idx & 15; float kf[8], qf8[8];
            const uint4 kraw = *(const uint4*)(KN + (size_t)(row0 + n) * 512 + h * 128 + seg * 8), qraw = *(const uint4*)(QN + (size_t)(row0 + n) * 512 + h * 128 + seg * 8);
            unpack8(kraw, kf); unpack8(qraw, qf8);
            *(__attribute__((address_space(3))) u32x4*)(Kb + n * 272 + seg * 16) = (u32x4){kraw.x, kraw.y, kraw.z, kraw.w}; *(__attribute__((address_space(3))) u32x4*)(Qb + n * 272 + seg * 16) = (u32x4){qraw.x, qraw.y, qraw.z, qraw.w};
            *(float4*)(Kl + n * 132 + seg * 8) = make_float4(kf[0], kf[1], kf[2], kf[3]); *(float4*)(Kl + n * 132 + seg * 8 + 4) = make_float4(kf[4], kf[5], kf[6], kf[7]);
            *(float4*)(Ql + n * 132 + seg * 8) = make_float4(qf8[0], qf8[1], qf8[2], qf8[3]); *(float4*)(Ql + n * 132 + seg * 8 + 4) = make_float4(qf8[4], qf8[5], qf8[6], qf8[7]); }
        if (t < 64) {
            const int n = d ? 63 - t : t;
            float x = LA[(size_t)(row0 + n) * 8 + d * 4 + h];
#pragma unroll
            for (int o = 1; o < 64; o <<= 1) { const float y = __shfl_up(x, o); if (t >= o) x += y; }
            Gn[d * 64 + n] = x; Bn[d * 64 + n] = BE[(size_t)(row0 + n) * 8 + d * 4 + h];
        }
        __syncthreads();
        {
            int tb = tid; asm volatile("" : "+v"(tb));
            const int lane = tb & 63, wv = tb >> 6, r = lane & 31, hh = lane >> 5, sel = wv >> 2, it = (wv >> 1) & 1, jt = wv & 1;
            const lb Ab = sel ? Qb : Kb;
            f32x16 acc;
#pragma unroll
            for (int i = 0; i < 16; ++i) acc[i] = 0.f;
#pragma unroll
            for (int ks = 0; ks < 8; ++ks) { const bf16x8 a = *(const __attribute__((address_space(3))) bf16x8*)(Ab + (32 * it + r) * 272 + (16 * ks + 8 * hh) * 2);
                const bf16x8 bb = *(const __attribute__((address_space(3))) bf16x8*)(Kb + (32 * jt + r) * 272 + (16 * ks + 8 * hh) * 2); acc = MFMA32(a, bb, acc); }
            const int nj = 32 * jt + r; const float g0j = Gn[nj], g1j = Gn[64 + nj];
            if (sel == 0) {
#pragma unroll
                for (int i = 0; i < 16; ++i) { const int ni = 32 * it + (i & 3) + 8 * (i >> 2) + 4 * hh;
                    if (ni > nj) Al[ni * 68 + nj] = Bn[ni] * acc[i] * __expf(Gn[ni] - g0j);
                    else if (ni < nj) Al[64 * 68 + (63 - ni) * 68 + (63 - nj)] = Bn[64 + ni] * acc[i] * __expf(Gn[64 + ni] - g1j); }
            } else {
                bf16_t* q0 = DQK + ((size_t)item * 64) * 64; bf16_t* q1 = DQK + ((size_t)(1152 + item) * 64) * 64;
#pragma unroll
                for (int i = 0; i < 16; ++i) { const int ni = 32 * it + (i & 3) + 8 * (i >> 2) + 4 * hh;
                    const float v0 = ni >= nj ? acc[i] * __expf(Gn[ni] - g0j) : 0.f, v1 = ni <= nj ? acc[i] * __expf(Gn[64 + ni] - g1j) : 0.f;
                    q0[ni * 64 + nj] = (bf16_t)f2bf(v0); q1[(63 - ni) * 64 + (63 - nj)] = (bf16_t)f2bf(v1); }
            }
        }
        __syncthreads();
        { float x[64];
          if (d == 0) dn_rhs<0>(x, VN, Kl, Gn, Bn, row0, h, t); else dn_rhs<1>(x, VN, Kl, Gn, Bn, row0, h, t);
          dn_solve_core(x, Al + d * 64 * 68);
          if (d == 0) dn_out<0>(x, Kl, Ql, Gn, DW, DQE, DKT, DUT, DEG, item, t); else dn_out<1>(x, Kl, Ql, Gn, DW, DQE, DKT, DUT, DEG, item, t); }
    }
}

#define MFMA16(a, b, c) __builtin_amdgcn_mfma_f32_16x16x32_bf16((a), (b), (c), 0, 0, 0)
constexpr int DS_PITCH = 272, DV_PITCH = 144, D_ST = 0, D_VN = 2 * 32 * DS_PITCH, D_EG = D_VN + 32 * DV_PITCH, D_OB = D_EG + 256;
DI void phase_dn_chunkrec(PrmC p, unsigned char* smem) {
    const bf16_t* DW = (const bf16_t*)(p->ws + OFF_DW); const bf16_t* DQE = (const bf16_t*)(p->ws + OFF_DQE); const bf16_t* DKT = (const bf16_t*)(p->ws + OFF_DKT); const bf16_t* DQK = (const bf16_t*)(p->ws + OFF_DQK);
    const bf16_t* DUT = (const bf16_t*)(p->ws + OFF_DUT); const float* DEG = (const float*)(p->ws + OFF_DEG);
    bf16_t* ODN = (bf16_t*)(p->ws + OFF_ODN);
    const int tid = opaque_tid(), lane = tid & 63, wave = tid >> 6, r16 = lane & 15, q4 = lane >> 4, rt = wave >> 1, ct = wave & 1;
    for (int item0 = bid(); item0 < 256; item0 += gdim()) {
        const int item = xcd_group_item(item0, gdim());
        const int sl = item & 3, dir = (item >> 2) & 1, h = (item >> 3) & 3, b = item >> 5, bh = b * 4 + h;
        f32x4 Sacc[2];
        Sacc[0] = (f32x4){0.f, 0.f, 0.f, 0.f}; Sacc[1] = Sacc[0];
        __syncthreads();
        for (int i = tid; i < 32 * DS_PITCH / 16; i += NTHR) *(uint4*)(smem + D_ST + i * 16) = make_uint4(0, 0, 0, 0);
        uint4 wf0, wf1, wf2, wf3, qf0, qf1, qf2, qf3, qk0, qk1, kd00, kd01, kd10, kd11; uint2 uf;
        uint4 nwf0, nwf1, nwf2, nwf3, nqf0, nqf1, nqf2, nqf3, nqk0, nqk1, nkd00, nkd01, nkd10, nkd11; uint2 nuf;
#define DC_CIDX(ch) ((ch) < 4 ? (dir ? 3 - (ch) : (ch)) : 4 + (dir ? 35 - (ch) : (ch) - 4))
#define DC_LOAD(ch, P_) do { const size_t ci_ = (size_t)dir * 1152 + bh * 36 + DC_CIDX(ch); \
            const bf16_t* w_ = DW + (ci_ * 64 + 16 * rt + r16) * 128 + 8 * q4; const bf16_t* e_ = DQE + (ci_ * 64 + 16 * rt + r16) * 128 + 8 * q4; \
            P_##wf0 = *(const uint4*)(w_); P_##wf1 = *(const uint4*)(w_ + 32); P_##wf2 = *(const uint4*)(w_ + 64); P_##wf3 = *(const uint4*)(w_ + 96); \
            P_##qf0 = *(const uint4*)(e_); P_##qf1 = *(const uint4*)(e_ + 32); P_##qf2 = *(const uint4*)(e_ + 64); P_##qf3 = *(const uint4*)(e_ + 96); \
            const bf16_t* k_ = DQK + (ci_ * 64 + 16 * rt + r16) * 64 + 8 * q4; P_##qk0 = *(const uint4*)(k_); P_##qk1 = *(const uint4*)(k_ + 32); \
            const bf16_t* t_ = DKT + (ci_ * 128 + 32 * rt + r16) * 64 + 8 * q4; P_##kd00 = *(const uint4*)(t_); P_##kd01 = *(const uint4*)(t_ + 32); P_##kd10 = *(const uint4*)(t_ + 16 * 64); P_##kd11 = *(const uint4*)(t_ + 16 * 64 + 32); \
            P_##uf = *(const uint2*)(DUT + (ci_ * 128 + sl * 32 + 16 * ct + r16) * 64 + 16 * rt + 4 * q4); } while (0)
        if (tid < 36) ((float*)(smem + D_EG))[tid] = DEG[(size_t)dir * 1152 + bh * 36 + DC_CIDX(tid)];
        DC_LOAD(0, );
        __syncthreads();
#pragma unroll 1
        for (int ch = 0; ch < 36; ++ch) {
            if (ch + 1 < 36) DC_LOAD(ch + 1, n);
            const unsigned char* stc = smem + D_ST + (ch & 1) * 32 * DS_PITCH; unsigned char* stn = smem + D_ST + ((ch + 1) & 1) * 32 * DS_PITCH;
            f32x4 accW = (f32x4){0.f, 0.f, 0.f, 0.f}, accQ = accW;
            { const unsigned char* sb = stc + (16 * ct + r16) * DS_PITCH + 8 * q4 * 2;
              const bf16x8 s0 = *(const bf16x8*)(sb), s1 = *(const bf16x8*)(sb + 64), s2 = *(const bf16x8*)(sb + 128), s3 = *(const bf16x8*)(sb + 192);
              accW = MFMA16(__builtin_bit_cast(bf16x8, wf0), s0, accW); accW = MFMA16(__builtin_bit_cast(bf16x8, wf1), s1, accW); accW = MFMA16(__builtin_bit_cast(bf16x8, wf2), s2, accW); accW = MFMA16(__builtin_bit_cast(bf16x8, wf3), s3, accW);
              accQ = MFMA16(__builtin_bit_cast(bf16x8, qf0), s0, accQ); accQ = MFMA16(__builtin_bit_cast(bf16x8, qf1), s1, accQ); accQ = MFMA16(__builtin_bit_cast(bf16x8, qf2), s2, accQ); accQ = MFMA16(__builtin_bit_cast(bf16x8, qf3), s3, accQ); }
            { const float v0 = bf2f(uf.x & 0xffffu) - accW[0], v1 = __uint_as_float(uf.x & 0xffff0000u) - accW[1], v2 = bf2f(uf.y & 0xffffu) - accW[2], v3 = __uint_as_float(uf.y & 0xffff0000u) - accW[3];
              uint2 o; o.x = pk2(v0, v1); o.y = pk2(v2, v3);
              *(uint2*)(smem + D_VN + (16 * ct + r16) * DV_PITCH + (16 * rt + 4 * q4) * 2) = o; }
            __syncthreads();
            { const unsigned char* vb = smem + D_VN + (16 * ct + r16) * DV_PITCH + 8 * q4 * 2;
              const bf16x8 v0 = *(const bf16x8*)(vb), v1 = *(const bf16x8*)(vb + 64);
              accQ = MFMA16(__builtin_bit_cast(bf16x8, qk0), v0, accQ); accQ = MFMA16(__builtin_bit_cast(bf16x8, qk1), v1, accQ);
              const float egl = ((const float*)(smem + D_EG))[ch];
              Sacc[0] = Sacc[0] * egl; Sacc[1] = Sacc[1] * egl;
              Sacc[0] = MFMA16(__builtin_bit_cast(bf16x8, kd00), v0, Sacc[0]); Sacc[0] = MFMA16(__builtin_bit_cast(bf16x8, kd01), v1, Sacc[0]);
              Sacc[1] = MFMA16(__builtin_bit_cast(bf16x8, kd10), v0, Sacc[1]); Sacc[1] = MFMA16(__builtin_bit_cast(bf16x8, kd11), v1, Sacc[1]); }
            wf0 = nwf0; wf1 = nwf1; wf2 = nwf2; wf3 = nwf3; qf0 = nqf0; qf1 = nqf1; qf2 = nqf2; qf3 = nqf3; qk0 = nqk0; qk1 = nqk1; kd00 = nkd00; kd01 = nkd01; kd10 = nkd10; kd11 = nkd11; uf = nuf;
            asm volatile("" ::: "memory");
            { float* ob = (float*)(smem + D_OB) + ((ch % 12) * 64 + 16 * rt + 4 * q4) * 32 + 16 * ct + r16;
#pragma unroll
              for (int j = 0; j < 4; ++j) ob[j * 32] = accQ[j]; }
#pragma unroll
            for (int tt = 0; tt < 2; ++tt) { uint2 o; o.x = pk2(Sacc[tt][0], Sacc[tt][1]); o.y = pk2(Sacc[tt][2], Sacc[tt][3]);
                *(uint2*)(stn + (16 * ct + r16) * DS_PITCH + (32 * rt + 16 * tt + 4 * q4) * 2) = o; }
            __syncthreads();
            if (ch % 12 == 11) {
                const float* obf = (const float*)(smem + D_OB);
#pragma unroll 2
                for (int i = 0; i < 6; ++i) { const int idx = tid + i * NTHR, pos = idx >> 2, seg = idx & 3;
                    const float4 v0 = *(const float4*)(obf + pos * 32 + seg * 8), v1 = *(const float4*)(obf + pos * 32 + seg * 8 + 4);
                    uint4 o; o.x = pk2(v0.x, v0.y); o.y = pk2(v0.z, v0.w); o.z = pk2(v1.x, v1.y); o.w = pk2(v1.z, v1.w);
                    *(uint4*)(ODN + ((size_t)dir * T_ALL + seq_row(b, dir, (ch - 11) * 64 + pos)) * 512 + h * 128 + sl * 32 + seg * 8) = o; }
            }
        }
    }
#undef DC_CIDX
#undef DC_LOAD
}

DI bf16x8 pack_step(const f32x16& x, int s) {
    u32x4 q;
    asm volatile("v_cvt_pk_bf16_f32 %0, %4, %5\n\tv_cvt_pk_bf16_f32 %1, %6, %7\n\tv_cvt_pk_bf16_f32 %2, %8, %9\n\tv_cvt_pk_bf16_f32 %3, %10, %11\n\ts_nop 1"
                 : "=&v"(q[0]), "=&v"(q[1]), "=&v"(q[2]), "=&v"(q[3])
                 : "v"(x[8 * s]), "v"(x[8 * s + 1]), "v"(x[8 * s + 2]), "v"(x[8 * s + 3]), "v"(x[8 * s + 4]), "v"(x[8 * s + 5]), "v"(x[8 * s + 6]), "v"(x[8 * s + 7]));
    return __builtin_bit_cast(bf16x8, q);
}
constexpr int KPITCH = 272, VPITCH = 136, KBUF_B = 64 * KPITCH, VBUF_B = 128 * VPITCH;
DI void phase_attn(PrmC p, int ai, int layer, int n_items, unsigned char* smem) {
    const bf16_t* QD = (const bf16_t*)(p->ws + OFF_QD); const bf16_t* KD = (const bf16_t*)(p->ws + OFF_KD); const bf16_t* VT = (const bf16_t*)(p->ws + OFF_VT);
    bf16_t* Y = (bf16_t*)(p->ws + OFF_HY);
    const int tid = opaque_tid(), lane = tid & 63, wave = tid >> 6, qg = wave & 3, map = wave >> 2, r = lane & 31, hh = lane >> 5;
    asm volatile("" : "+s"(layer));
    float lam_full; const float lambda_init = 0.8f - 0.6f * __expf(-0.3f * (float)layer);
    { const float* lm = p->diff_lambda + (size_t)ai * 256; const float s1 = wave_sum(lm[lane] * lm[64 + lane]), s2 = wave_sum(lm[128 + lane] * lm[192 + lane]);
      lam_full = __expf(s1) - __expf(s2) + lambda_init; }
    unsigned char* kb0 = smem; unsigned char* vb0 = smem + 2 * KBUF_B;
    float* xch = (float*)smem;
    for (int item0 = bid(); item0 < n_items; item0 += gdim()) {
        int item = item0;
        if (gdim() == 256 && item0 < 512) { const int blk = item0 & 255, li = (item0 >> 8) * 32 + (blk >> 3); item = (((blk & 7) * 4 + (li >> 4)) << 4) + (li & 15); }
        int b, h, qpos0, nkt;
        if (item < 512) { b = item >> 6; h = (item >> 4) & 3; qpos0 = 256 + (item & 15) * 128; nkt = 36; }
        else { const int j = item - 512; b = j >> 3; h = (j >> 1) & 3; qpos0 = (j & 1) * 128; nkt = 4; }
        const int bh = b * 4 + h;
        const bf16_t* Kg = KD + (size_t)bh * 2304 * 128; const bf16_t* Vg = VT + (size_t)bh * 128 * 2304;
        bf16x8 qf[4];
        { const bf16_t* qp = QD + ((size_t)bh * 2304 + qpos0 + 32 * qg + r) * 128 + map * 64 + 8 * hh;
#pragma unroll
          for (int ks = 0; ks < 4; ++ks) qf[ks] = *(const bf16x8*)(qp + 16 * ks); }
        f32x16 O[4];
#pragma unroll
        for (int nt = 0; nt < 4; ++nt)
#pragma unroll
            for (int i = 0; i < 16; ++i) O[nt][i] = 0.f;
        float m = -1e30f, lsum = 0.f;
        uint4 kreg0, kreg1, vreg0, vreg1;
#define ATT_G1(i_, KR_, VR_, kt) { const int idx_ = tid + (i_) * NTHR; \
            KR_ = *(const uint4*)(Kg + (size_t)((kt) * 64 + (idx_ >> 4)) * 128 + (idx_ & 15) * 8); \
            VR_ = *(const uint4*)(Vg + (size_t)(idx_ >> 3) * 2304 + (kt) * 64 + (idx_ & 7) * 8); }
#define ATT_GLOAD(kt) do { ATT_G1(0, kreg0, vreg0, kt) ATT_G1(1, kreg1, vreg1, kt) } while (0)
#define ATT_S1(i_, KR_, VR_, bi) { const int idx_ = tid + (i_) * NTHR; \
            *(uint4*)(kb0 + (bi) * KBUF_B + (idx_ >> 4) * KPITCH + (idx_ & 15) * 16) = KR_; \
            *(uint2*)(vb0 + (bi) * VBUF_B + (idx_ >> 3) * VPITCH + (idx_ & 7) * 16) = make_uint2(VR_.x, VR_.y); *(uint2*)(vb0 + (bi) * VBUF_B + (idx_ >> 3) * VPITCH + (idx_ & 7) * 16 + 8) = make_uint2(VR_.z, VR_.w); }
#define ATT_LSTORE(bi) do { ATT_S1(0, kreg0, vreg0, bi) ATT_S1(1, kreg1, vreg1, bi) } while (0)
        __syncthreads();
        ATT_GLOAD(0); ATT_LSTORE(0);
        __syncthreads();
        for (int kt = 0; kt < nkt; ++kt) {
            const unsigned char* kb = kb0 + (kt & 1) * KBUF_B; const unsigned char* vb = vb0 + (kt & 1) * VBUF_B;
            if (kt + 1 < nkt) ATT_GLOAD(kt + 1);
            {
                f32x16 S0, S1;
#pragma unroll
                for (int i = 0; i < 16; ++i) { S0[i] = 0.f; S1[i] = 0.f; }
#pragma unroll
                for (int ks = 0; ks < 4; ++ks) {
                    const bf16x8 a0 = *(const bf16x8*)(kb + r * KPITCH + map * 128 + (16 * ks + 8 * hh) * 2);
                    const bf16x8 a1 = *(const bf16x8*)(kb + (32 + r) * KPITCH + map * 128 + (16 * ks + 8 * hh) * 2);
                    S0 = MFMA32(a0, qf[ks], S0); S1 = MFMA32(a1, qf[ks], S1); }
                float tmax = fmaxf(S0[0], S1[0]);
#pragma unroll
                for (int i = 1; i < 16; ++i) tmax = fmaxf(tmax, fmaxf(S0[i], S1[i]));
                if (__any(tmax > m + 8.0f)) {
                    tmax = fmaxf(tmax, __shfl_xor(tmax, 32));
                    const float mn = fmaxf(m, tmax), alpha = __builtin_amdgcn_exp2f(m - mn);
                    m = mn; lsum *= alpha;
#pragma unroll
                    for (int nt = 0; nt < 4; ++nt)
#pragma unroll
                        for (int i = 0; i < 16; ++i) O[nt][i] *= alpha;
                }
#pragma unroll
                for (int i = 0; i < 16; ++i) { S0[i] = __builtin_amdgcn_exp2f(S0[i] - m); S1[i] = __builtin_amdgcn_exp2f(S1[i] - m); lsum += S0[i] + S1[i]; }
#pragma unroll
                for (int sub = 0; sub < 2; ++sub)
#pragma unroll
                    for (int s = 0; s < 2; ++s) {
                        const bf16x8 pb = pack_step(sub ? S1 : S0, s);
#pragma unroll
                        for (int nt = 0; nt < 4; ++nt) {
                            const unsigned char* va = vb + (32 * nt + r) * VPITCH + (32 * sub + 16 * s + 4 * hh) * 2;
                            const uint2 lo = *(const uint2*)va, hi = *(const uint2*)(va + 16);
                            const uint4 av = make_uint4(lo.x, lo.y, hi.x, hi.y);
                            O[nt] = MFMA32(__builtin_bit_cast(bf16x8, av), pb, O[nt]);
                        }
                    }
            }
            if (kt + 1 < nkt) ATT_LSTORE((kt + 1) & 1);
            __syncthreads();
        }
        lsum += __shfl_xor(lsum, 32);
        const float inv = 1.0f / lsum;
        if (map == 1) {
            const float sc = lam_full * inv;
#pragma unroll
            for (int nt = 0; nt < 4; ++nt)
#pragma unroll
                for (int i = 0; i < 16; ++i) xch[(qg * 128 + 32 * nt + (i & 3) + 8 * (i >> 2) + 4 * hh) * 32 + r] = O[nt][i] * sc;
        }
        __syncthreads();
        if (map == 0) {
            float ss = 0.f;
#pragma unroll
            for (int nt = 0; nt < 4; ++nt)
#pragma unroll
                for (int i = 0; i < 16; ++i) { const float o = O[nt][i] * inv - xch[(qg * 128 + 32 * nt + (i & 3) + 8 * (i >> 2) + 4 * hh) * 32 + r]; O[nt][i] = o; ss += o * o; }
            ss += __shfl_xor(ss, 32);
            const float rstd = rsqrtf(ss * (1.0f / 128.0f) + 1e-6f) * (1.0f - lambda_init);
            const int pos = qpos0 + 32 * qg + r;
            const int row = pos >= 256 ? b * 2048 + (pos - 256) : T_LAT + b * 256 + pos;
            const float* sw = p->diff_subln_w + (size_t)ai * 128;
            bf16_t* yo = row < T_LAT ? Y + (size_t)row * 1024 + 512 + h * 128 : Y + (size_t)T_LAT * 1024 + ((size_t)2048 + (row - T_LAT)) * 512 + h * 128;
#pragma unroll
            for (int nt = 0; nt < 4; ++nt)
#pragma unroll
                for (int g4 = 0; g4 < 4; ++g4) { const int dv = 32 * nt + 8 * g4 + 4 * hh; const float4 w = *(const float4*)(sw + dv);
                    uint2 o; o.x = pk2(O[nt][4 * g4 + 0] * rstd * w.x, O[nt][4 * g4 + 1] * rstd * w.y); o.y = pk2(O[nt][4 * g4 + 2] * rstd * w.z, O[nt][4 * g4 + 3] * rstd * w.w);
                    *(uint2*)(yo + dv) = o; }
        }
    }
#undef ATT_GLOAD
#undef ATT_LSTORE
}

DI void phase_dn_merge(PrmC p, int ai, int nrows, int gw, int NGW) {
    const bf16_t* ODN = (const bf16_t*)(p->ws + OFF_ODN); const bf16_t* P = (const bf16_t*)(p->ws + OFF_ABP); bf16_t* Y = (bf16_t*)(p->ws + OFF_HY);
    const int lane = opaque_tid() & 63;
    const float* nw = p->dn_norm_w + (size_t)ai * 128 + (lane & 15) * 8;
    const float4 w0 = *(const float4*)nw, w1 = *(const float4*)(nw + 4);
    const float wv[8] = {w0.x, w0.y, w0.z, w0.w, w1.x, w1.y, w1.z, w1.w};
    for (int rowa = gw; rowa < nrows; rowa += 2 * NGW) {
        const int rowb = rowa + NGW < nrows ? rowa + NGW : rowa;
        const uint4 a0 = *(const uint4*)(ODN + (size_t)rowa * 512 + lane * 8), a1 = *(const uint4*)(ODN + ((size_t)T_ALL + rowa) * 512 + lane * 8), za = *(const uint4*)(P + (size_t)rowa * 3840 + 1536 + lane * 8);
        const uint4 b0 = *(const uint4*)(ODN + (size_t)rowb * 512 + lane * 8), b1 = *(const uint4*)(ODN + ((size_t)T_ALL + rowb) * 512 + lane * 8), zb = *(const uint4*)(P + (size_t)rowb * 3840 + 1536 + lane * 8);
#pragma unroll
        for (int rr = 0; rr < 2; ++rr) {
            const int row = rr ? rowb : rowa;
            float o[8], o2[8], z[8]; unpack8(rr ? b0 : a0, o); unpack8(rr ? b1 : a1, o2); unpack8(rr ? zb : za, z);
            float ss = 0.f;
#pragma unroll
            for (int e = 0; e < 8; ++e) { o[e] += o2[e]; ss += o[e] * o[e]; }
            ss = sum16(ss);
            const float rstd = rsqrtf(ss * (1.0f / 128.0f) + 1e-6f);
            float y[8];
#pragma unroll
            for (int e = 0; e < 8; ++e) y[e] = o[e] * rstd * wv[e] * silu_f(z[e]);
            *(uint4*)(row < T_LAT ? Y + (size_t)row * 1024 + lane * 8 : Y + (size_t)T_LAT * 1024 + (size_t)(row - T_LAT) * 512 + lane * 8) = pack8(y);
        }
    }
}

DI void phase_ret_prep(PrmC p, int ri, unsigned char* smem) {
    const bf16_t* P0 = (const bf16_t*)(p->ws + OFF_RP); const bf16_t* P1 = P0 + RP_STRIDE;
    bf16_t* QR = (bf16_t*)(p->ws + OFF_QR); bf16_t* KR = (bf16_t*)(p->ws + OFF_KR);
    bf16_t* KDT = (bf16_t*)(p->ws + OFF_KDT); bf16_t* VTR = (bf16_t*)(p->ws + OFF_VTR);
    const float2* RT = (const float2*)(p->ws + OFF_ROPE_RET);
    bf16_t* kt_l = (bf16_t*)smem;
    bf16_t* vt_l = (bf16_t*)(smem + 64 * 528);
    float* dec_l = (float*)(smem + 64 * 528 + 64 * 1040);
    const int tid = opaque_tid(), lane = tid & 63, wave = tid >> 6;
    for (int item = bid(); item < 288 * 4; item += gdim()) {
        const int g = item >> 2, hp = item & 3, row0 = g * 64; const bool lat = row0 < T_LAT;
        __syncthreads();
#pragma unroll
        for (int i = 0; i < 8; ++i) { const int idx = tid + i * NTHR, pos = idx >> 6, seg = idx & 63;
            *(uint4*)(vt_l + pos * 520 + seg * 8) = *(const uint4*)(P1 + (size_t)(row0 + pos) * 2048 + hp * 512 + seg * 8); }
        if (tid < 256) { const int j = tid & 63, hh2 = (tid >> 6) & 1, dir2 = tid >> 7; const float dl = p->ret_decay_logit[(size_t)ri * 16 + dir2 * 8 + 2 * hp + hh2];
            dec_l[tid] = exp2f(-log1pf(__expf(-dl)) * 1.4426950408889634f * (float)(dir2 ? j : 63 - j)); }
        { const int l32 = lane & 31, c = l32 * 8, wo = c & 127; const bool firsth = wo < 64;
#pragma unroll 2
          for (int tp = 0; tp < 4; ++tp) {
              const int pos = 8 * wave + 2 * tp + (lane >> 5), row = row0 + pos;
              float q[8], k[8]; unpack8(*(const uint4*)(P0 + (size_t)row * 2048 + hp * 256 + c), q); unpack8(*(const uint4*)(P0 + (size_t)row * 2048 + 1024 + hp * 256 + c), k);
              if (lat) {
                  const float2* rt = RT + (size_t)(row & 2047) * 64 + (wo & 63);
#pragma unroll
                  for (int e = 0; e < 8; ++e) { const float2 cs = rt[e]; const float qp = __shfl_xor(q[e], 8), kp = __shfl_xor(k[e], 8);
                      q[e] = q[e] * cs.x + (firsth ? -qp : qp) * cs.y; k[e] = k[e] * cs.x + (firsth ? -kp : kp) * cs.y; }
              }
#pragma unroll
              for (int e = 0; e < 8; ++e) k[e] *= 0.08838834764831845f;
              const uint4 kq = pack8(k);
              *(uint4*)(QR + (size_t)row * 1024 + hp * 256 + c) = pack8(q); *(uint4*)(KR + (size_t)row * 1024 + hp * 256 + c) = kq;
              *(uint4*)(kt_l + pos * 264 + c) = kq;
          } }
        __syncthreads();
#pragma unroll 2
        for (int i = 0; i < 8; ++i) {
            const int q = tid + i * NTHR, dk = q & 127, pg = (q >> 7) & 7, hh = (q >> 10) & 1, dir = (q >> 11) & 1, h = 2 * hp + hh;
            float v[8];
#pragma unroll
            for (int e = 0; e < 8; ++e) { const int j = 8 * pg + e; v[e] = bf2f(kt_l[j * 264 + hh * 128 + dk]) * dec_l[(dir * 2 + hh) * 64 + j]; }
            *(uint4*)(KDT + ((((size_t)dir * 288 + g) * 8 + h) * 128 + dk) * 64 + 8 * pg) = pack8(v);
        }
#pragma unroll 2
        for (int i = 0; i < 8; ++i) {
            const int q = tid + i * NTHR, dvi = q & 255, pg = (q >> 8) & 7, hh = q >> 11, h = 2 * hp + hh;
            unsigned w[4];
#pragma unroll
            for (int e = 0; e < 4; ++e) w[e] = (unsigned)vt_l[(8 * pg + 2 * e) * 520 + hh * 256 + dvi] | ((unsigned)vt_l[(8 * pg + 2 * e + 1) * 520 + hh * 256 + dvi] << 16);
            *(uint4*)(VTR + (((size_t)g * 8 + h) * 256 + dvi) * 64 + 8 * pg) = make_uint4(w[0], w[1], w[2], w[3]);
        }
    }
}

constexpr int RQ_PITCH = 272, RT_PITCH = 144;
constexpr int R_QL = 0, R_KL = 64 * RQ_PITCH, R_KTL = 2 * 64 * RQ_PITCH, R_VTL = R_KTL + 128 * RT_PITCH, R_ST = R_VTL + 128 * RT_PITCH;
DI void phase_ret_chunk(PrmC p, int ri, unsigned char* smem, bool skip_ctx_out) {
    const bf16_t* QR = (const bf16_t*)(p->ws + OFF_QR); const bf16_t* KR = (const bf16_t*)(p->ws + OFF_KR);
    const bf16_t* KDT = (const bf16_t*)(p->ws + OFF_KDT); const bf16_t* VTR = (const bf16_t*)(p->ws + OFF_VTR);
    bf16_t* ORp = (bf16_t*)(p->ws + OFF_OR);
    const int tid = opaque_tid(), lane = tid & 63, wave = tid >> 6, r = lane & 31, hh = lane >> 5;
    const int dvt = wave >> 1, it = wave & 1, dkt = wave >> 1, dv2 = 2 * (wave & 1);
    typedef __attribute__((address_space(3))) unsigned char* lbp;
    unsigned stb_ = R_ST; asm volatile("" : "+v"(stb_)); const lbp stl = (lbp)(uintptr_t)stb_;
    for (int item0 = bid(); item0 < 256; item0 += gdim()) {
        const int item = xcd_group_item(item0, gdim());
        const int sl = item & 1, dir = (item >> 1) & 1, h = (item >> 2) & 7, b = item >> 5;
        const float dl = p->ret_decay_logit[(size_t)ri * 16 + dir * 8 + h];
        const float lg2 = -log1pf(__expf(-dl)) * 1.4426950408889634f;
        const float cdec = exp2f(lg2 * 64.0f);
        const int ii = 32 * it + r;
        const float rowscale = exp2f(lg2 * (float)(dir ? 64 - ii : ii + 1));
        __attribute__((address_space(3))) float* gtab = (__attribute__((address_space(3))) float*)(stl + 128 * RQ_PITCH);
        __syncthreads();
        if (tid < 32) { const int rg = tid & 15, h2 = tid >> 4, jl = (rg & 3) + 8 * (rg >> 2) + 4 * h2; gtab[tid] = exp2f(lg2 * (float)(dir ? jl : -jl)); }
        const float gi0 = exp2f(lg2 * (float)(dir ? -ii : ii)), gi1 = gi0 * exp2f(lg2 * (dir ? 32.0f : -32.0f));
        f32x16 Sacc[2];
#pragma unroll
        for (int t = 0; t < 2; ++t)
#pragma unroll
            for (int i = 0; i < 16; ++i) Sacc[t][i] = 0.f;
        uint4 q0, q1, k0, k1, t0, t1, v0, v1;
#define RC_ROW0(ch) ((ch) < 4 ? T_LAT + b * 256 + (dir ? 3 - (ch) : (ch)) * 64 : b * 2048 + (dir ? 35 - (ch) : (ch) - 4) * 64)
#define RC_GLOAD(ch) do { const int row0_ = RC_ROW0(ch), g_ = row0_ >> 6; \
            { const int idx_ = tid, pos_ = idx_ >> 4, seg_ = idx_ & 15; q0 = *(const uint4*)(QR + (size_t)(row0_ + pos_) * 1024 + h * 128 + seg_ * 8); k0 = *(const uint4*)(KR + (size_t)(row0_ + pos_) * 1024 + h * 128 + seg_ * 8); } \
            { const int idx_ = tid + NTHR, pos_ = idx_ >> 4, seg_ = idx_ & 15; q1 = *(const uint4*)(QR + (size_t)(row0_ + pos_) * 1024 + h * 128 + seg_ * 8); k1 = *(const uint4*)(KR + (size_t)(row0_ + pos_) * 1024 + h * 128 + seg_ * 8); } \
            { const bf16_t* kd_ = KDT + (((size_t)dir * 288 + g_) * 8 + h) * 8192; const bf16_t* vt_ = VTR + (((size_t)g_ * 8 + h) * 256 + sl * 128) * 64; \
              t0 = *(const uint4*)(kd_ + tid * 8); t1 = *(const uint4*)(kd_ + (tid + NTHR) * 8); v0 = *(const uint4*)(vt_ + tid * 8); v1 = *(const uint4*)(vt_ + (tid + NTHR) * 8); } } while (0)
#define RC_LSTORE() do { \
            { const int idx_ = tid, pos_ = idx_ >> 4, seg_ = idx_ & 15; *(uint4*)(smem + R_QL + pos_ * RQ_PITCH + seg_ * 16) = q0; *(uint4*)(smem + R_KL + pos_ * RQ_PITCH + seg_ * 16) = k0; } \
            { const int idx_ = tid + NTHR, pos_ = idx_ >> 4, seg_ = idx_ & 15; *(uint4*)(smem + R_QL + pos_ * RQ_PITCH + seg_ * 16) = q1; *(uint4*)(smem + R_KL + pos_ * RQ_PITCH + seg_ * 16) = k1; } \
            { const int idx_ = tid, rw_ = idx_ >> 3, seg_ = idx_ & 7; *(uint4*)(smem + R_KTL + rw_ * RT_PITCH + seg_ * 16) = t0; *(uint4*)(smem + R_VTL + rw_ * RT_PITCH + seg_ * 16) = v0; } \
            { const int idx_ = tid + NTHR, rw_ = idx_ >> 3, seg_ = idx_ & 7; *(uint4*)(smem + R_KTL + rw_ * RT_PITCH + seg_ * 16) = t1; *(uint4*)(smem + R_VTL + rw_ * RT_PITCH + seg_ * 16) = v1; } } while (0)
        __syncthreads();
        for (int i = tid; i < 128 * RQ_PITCH / 16; i += NTHR) *(__attribute__((address_space(3))) u32x4*)(stl + i * 16) = (u32x4){0u, 0u, 0u, 0u};
        RC_GLOAD(0);
        for (int ch = 0; ch < 36; ++ch) {
            RC_LSTORE();
            __syncthreads();
            const int row0 = RC_ROW0(ch);
            if (ch + 1 < 36) RC_GLOAD(ch + 1);
            if (!(skip_ctx_out && ch < 4)) {
            int iil = ii; asm volatile("" : "+v"(iil));
            const bool use0 = dir ? (it == 0) : true, use1 = dir ? true : (it == 1);
            f32x16 acc, Sx0, Sx1;
#pragma unroll
            for (int i = 0; i < 16; ++i) { acc[i] = 0.f; Sx0[i] = 0.f; Sx1[i] = 0.f; }
#pragma unroll
            for (int ks = 0; ks < 8; ++ks) {
                const bf16x8 qf = *(const bf16x8*)(smem + R_QL + ii * RQ_PITCH + (16 * ks + 8 * hh) * 2);
                const bf16x8 a = *(const __attribute__((address_space(3))) bf16x8*)(stl + (32 * dvt + r) * RQ_PITCH + (16 * ks + 8 * hh) * 2);
                acc = MFMA32(a, qf, acc);
                if (use0) { const bf16x8 k0f = *(const bf16x8*)(smem + R_KL + r * RQ_PITCH + (16 * ks + 8 * hh) * 2); Sx0 = MFMA32(k0f, qf, Sx0); }
                if (use1) { const bf16x8 k1f = *(const bf16x8*)(smem + R_KL + (32 + r) * RQ_PITCH + (16 * ks + 8 * hh) * 2); Sx1 = MFMA32(k1f, qf, Sx1); }
            }
#pragma unroll
            for (int i = 0; i < 16; ++i) acc[i] *= rowscale;
            if (use0) {
#pragma unroll
                for (int i = 0; i < 16; ++i) { const int j = (i & 3) + 8 * (i >> 2) + 4 * hh; const bool keep = dir ? (j >= iil) : (iil >= j); Sx0[i] = keep ? Sx0[i] * (gi0 * gtab[hh * 16 + i]) : 0.f; }
#pragma unroll
                for (int s = 0; s < 2; ++s) {
                    const bf16x8 pb = pack_step(Sx0, s);
                    const unsigned char* va = smem + R_VTL + (32 * dvt + r) * RT_PITCH + (16 * s + 4 * hh) * 2;
                    const uint2 lo = *(const uint2*)va, hi = *(const uint2*)(va + 16);
                    acc = MFMA32(__builtin_bit_cast(bf16x8, make_uint4(lo.x, lo.y, hi.x, hi.y)), pb, acc);
                }
            }
            if (use1) {
#pragma unroll
                for (int i = 0; i < 16; ++i) { const int j = 32 + (i & 3) + 8 * (i >> 2) + 4 * hh; const bool keep = dir ? (j >= iil) : (iil >= j); Sx1[i] = keep ? Sx1[i] * (gi1 * gtab[hh * 16 + i]) : 0.f; }
#pragma unroll
                for (int s = 0; s < 2; ++s) {
                    const bf16x8 pb = pack_step(Sx1, s);
                    const unsigned char* va = smem + R_VTL + (32 * dvt + r) * RT_PITCH + (32 + 16 * s + 4 * hh) * 2;
                    const uint2 lo = *(const uint2*)va, hi = *(const uint2*)(va + 16);
                    acc = MFMA32(__builtin_bit_cast(bf16x8, make_uint4(lo.x, lo.y, hi.x, hi.y)), pb, acc);
                }
            }
            { bf16_t* op = ORp + ((size_t)dir * T_ALL + row0 + ii) * 2048 + h * 256 + sl * 128 + 32 * dvt + 4 * hh;
#pragma unroll
              for (int g4 = 0; g4 < 4; ++g4) { uint2 o; o.x = cvt_pk_bf16(acc[4 * g4], acc[4 * g4 + 1]); o.y = cvt_pk_bf16(acc[4 * g4 + 2], acc[4 * g4 + 3]); *(uint2*)(op + 8 * g4) = o; } }
            }
#pragma unroll
            for (int t = 0; t < 2; ++t) {
#pragma unroll
                for (int i = 0; i < 16; ++i) Sacc[t][i] *= cdec;
#pragma unroll
                for (int ks = 0; ks < 4; ++ks) {
                    const bf16x8 a = *(const bf16x8*)(smem + R_KTL + (32 * dkt + r) * RT_PITCH + (16 * ks + 8 * hh) * 2);
                    const bf16x8 bb = *(const bf16x8*)(smem + R_VTL + (32 * (dv2 + t) + r) * RT_PITCH + (16 * ks + 8 * hh) * 2);
                    Sacc[t] = MFMA32(a, bb, Sacc[t]);
                }
            }
            __syncthreads();
#pragma unroll
            for (int t = 0; t < 2; ++t)
#pragma unroll
                for (int g4 = 0; g4 < 4; ++g4) { u32x2_t o; o.x = cvt_pk_bf16(Sacc[t][4 * g4], Sacc[t][4 * g4 + 1]); o.y = cvt_pk_bf16(Sacc[t][4 * g4 + 2], Sacc[t][4 * g4 + 3]);
                    *(__attribute__((address_space(3))) u32x2_t*)(stl + (32 * (dv2 + t) + r) * RQ_PITCH + (32 * dkt + 8 * g4 + 4 * hh) * 2) = o; }
        }
    }
#undef RC_ROW0
#undef RC_GLOAD
#undef RC_LSTORE
}

DI void phase_ret_merge(PrmC p, int nrows, int gw, int NGW) {
    const bf16_t* ORp = (const bf16_t*)(p->ws + OFF_OR); const bf16_t* PG = (const bf16_t*)(p->ws + OFF_RP) + 2 * RP_STRIDE; bf16_t* Y = (bf16_t*)(p->ws + OFF_HY);
    const int lane = opaque_tid() & 63;
    for (int row = gw; row < nrows; row += NGW) {
        uint4 ra[4], rc[4], rz[4];
#pragma unroll
        for (int g = 0; g < 4; ++g) { const size_t off = (size_t)row * 2048 + g * 512 + lane * 8;
            ra[g] = *(const uint4*)(ORp + off); rc[g] = *(const uint4*)(ORp + (size_t)T_ALL * 2048 + off); rz[g] = *(const uint4*)(PG + off); }
#pragma unroll
        for (int g = 0; g < 4; ++g) {
            const size_t off = (size_t)row * 2048 + g * 512 + lane * 8;
            float a[8], c[8], z[8]; unpack8(ra[g], a); unpack8(rc[g], c); unpack8(rz[g], z);
            float ss = 0.f;
#pragma unroll
            for (int e = 0; e < 8; ++e) { a[e] += c[e]; ss += a[e] * a[e]; }
            ss = sum16(ss); ss += __shfl_xor(ss, 16);
            const float rstd = rsqrtf(ss * (1.0f / 256.0f) + 1e-6f);
#pragma unroll
            for (int e = 0; e < 8; ++e) a[e] = a[e] * rstd * silu_f(z[e]);
            *(uint4*)(row < T_LAT ? Y + off : Y + (size_t)T_LAT * 2048 + ((size_t)(g >> 1) * 2048 + (row - T_LAT)) * 1024 + (g & 1) * 512 + lane * 8) = pack8(a);
        }
    }
}

DI void phase_final(PrmC p, int gw, int NGW) {
    const float* X = (const float*)(p->ws + OFF_X);
    const int lane = opaque_tid() & 63;
    for (int row = gw; row < T_LAT; row += NGW) {
        const float* xr = X + (size_t)row * 1024;
        float4 v[4]; float ss = 0.f;
#pragma unroll
        for (int j = 0; j < 4; ++j) { v[j] = *(const float4*)(xr + j * 256 + lane * 4); ss += v[j].x * v[j].x + v[j].y * v[j].y + v[j].z * v[j].z + v[j].w * v[j].w; }
        const float rstd = rsqrtf(wave_sum(ss) * (1.0f / 1024.0f) + 1e-6f);
#pragma unroll
        for (int j = 0; j < 4; ++j) { const int c = j * 256 + lane * 4; const float4 w = *(const float4*)(p->final_norm_w + c);
            *(float4*)(p->out + (size_t)row * 1024 + c) = make_float4(v[j].x * rstd * w.x, v[j].y * rstd * w.y, v[j].z * rstd * w.z, v[j].w * rstd * w.w); }
    }
}


#define LAS __attribute__((address_space(3)))
#define XB_TMO      128
#define XB_XCNT(j)  (256  + 64 * (j))
#define XB_XSUB(j)  (1280 + 64 * (j))
#define XB_XGEN(j)  (2304 + 64 * (j))
#define XB_TOP      3328
#define XB_TOPGEN   3392
#define XCD_BAR_WORDS 3456
#define XB_SPIN_CAP (1u << 18)

__device__ __forceinline__ unsigned xb_ld(unsigned* p)              { return __hip_atomic_load(p, __ATOMIC_RELAXED, __HIP_MEMORY_SCOPE_AGENT); }
__device__ __forceinline__ unsigned xb_add(unsigned* p, unsigned v) { return __hip_atomic_fetch_add(p, v, __ATOMIC_RELAXED, __HIP_MEMORY_SCOPE_AGENT); }
__device__ __forceinline__ unsigned xb_xcc_id() { return (unsigned)__builtin_amdgcn_s_getreg((3 << 11) | 20) & 0xFu; }
#define XB_SPIN(cond, bar) do { unsigned _sp = 0; while (cond) { __builtin_amdgcn_s_sleep(1); \
    if ((++_sp & 255u) == 0u) { if (xb_ld(&(bar)[XB_TMO])) break; if (_sp > XB_SPIN_CAP) { atomicAdd(&(bar)[XB_TMO], 1u); break; } } } } while (0)

struct XcdBarrier {
    unsigned* bar; unsigned x;
    volatile LAS unsigned* st;
};

__device__ __forceinline__ XcdBarrier xcd_barrier_post(unsigned* bar, volatile LAS unsigned* st) {
    XcdBarrier b; b.bar = bar; b.x = xb_xcc_id(); b.st = st;
    if (threadIdx.x == 0) (void)xb_add(&bar[XB_XCNT(b.x)], 1u);
    return b;
}
__device__ __forceinline__ void xcd_barrier_complete(unsigned* bar, unsigned x, unsigned& nloc, unsigned& nx) {
    const unsigned G = gridDim.x * gridDim.y * gridDim.z;
    unsigned sum, cnt, mine, sp = 0u;
    for (;;) {
        sum = 0u; cnt = 0u; mine = 0u;
#pragma unroll
        for (unsigned j = 0; j < 16; ++j) { const unsigned c = xb_ld(&bar[XB_XCNT(j)]); sum += c; cnt += (c > 0u) ? 1u : 0u; mine = (j == x) ? c : mine; }
        if (sum == G) break;
        __builtin_amdgcn_s_sleep(1);
        if ((++sp & 255u) == 0u) { if (xb_ld(&bar[XB_TMO])) break; if (sp > XB_SPIN_CAP) { atomicAdd(&bar[XB_TMO], 1u); break; } }
    }
    nloc = mine > 0u ? mine : 1u; nx = cnt > 0u ? cnt : 1u;
}

__device__ __forceinline__ void xcd_barrier(const XcdBarrier& b) {
    asm volatile("s_waitcnt vmcnt(0)" ::: "memory");
    __syncthreads();
    if (threadIdx.x == 0) {
        unsigned* bar = b.bar;
        __builtin_amdgcn_s_waitcnt(0);
        unsigned nloc = b.st[0], nx = b.st[1];
        if (nloc == 0u) { xcd_barrier_complete(bar, b.x, nloc, nx); b.st[0] = nloc; b.st[1] = nx; }
        const unsigned old = xb_add(&bar[XB_XSUB(b.x)], 1u);
        const unsigned gen = old / nloc;
        if (old + 1u == (gen + 1u) * nloc) {
            __builtin_amdgcn_fence(__ATOMIC_RELEASE, "agent");
            asm volatile("s_waitcnt vmcnt(0)" ::: "memory");
            const unsigned og = xb_add(&bar[XB_TOP], 1u);
            const unsigned tg = og / nx;
            if (og + 1u == (tg + 1u) * nx) xb_add(&bar[XB_TOPGEN], 1u);
            else XB_SPIN(xb_ld(&bar[XB_TOPGEN]) == tg, bar);
            __builtin_amdgcn_fence(__ATOMIC_ACQUIRE, "agent");
            xb_add(&bar[XB_XGEN(b.x)], 1u);
            asm volatile("s_waitcnt vmcnt(0)" ::: "memory");
        } else {
            XB_SPIN(xb_ld(&bar[XB_XGEN(b.x)]) == gen, bar);
            __builtin_amdgcn_fence(__ATOMIC_ACQUIRE, "agent");
            asm volatile("s_waitcnt vmcnt(0)" ::: "memory");
        }
    }
    __syncthreads();
}


constexpr int LDS_BYTES = 152 * 1024;
#ifndef PROBE_ST5
#define PROBE_ST5 1
#endif
#ifndef PROBE_ST6
#define PROBE_ST6 1
#endif
#ifndef PROBE_ST7
#define PROBE_ST7 1
#endif
#ifndef PROBE_ST8
#define PROBE_ST8 1
#endif
DI int probe_n(int n) { asm volatile("" : "+s"(n)); return n; }
#define PROBE_LOOP(n) _Pragma("unroll 1") for (int rep_ = 0, nrep_ = ((n) > 1 ? probe_n(n) : 1); rep_ < nrep_; ++rep_)
constexpr int N_PHASES = 1 + 4 * 13 + 1;

__global__ void __launch_bounds__(NTHR, 2) fwd_megakernel(Prm p_unused, int lo, int hi) {
    extern __shared__ __attribute__((aligned(16))) unsigned char smem[];
    cg::grid_group grid = cg::this_grid();
    { const int t0 = opaque_tid(); if (t0 < 4) ((volatile LAS unsigned*)(LAS unsigned char*)(smem + LDS_BYTES - 16))[t0] = 0u; }
    __syncthreads();
    if (hi - lo > 1) { PrmC p0 = get_prm(); (void)xcd_barrier_post((unsigned*)(p0->ws + OFF_BAR), (volatile LAS unsigned*)(LAS unsigned char*)(smem + LDS_BYTES - 16)); }
#define PHASE_LOCALS const int wave = __builtin_amdgcn_readfirstlane(opaque_tid() >> 6); const int G = gdim(), gw = bid() * 8 + wave, NGW = G * 8; float* scr = (float*)smem + wave * (64 * 68); pg8_lds_t lds = (pg8_lds_t)smem; (void)scr; (void)lds; (void)gw; (void)NGW;
    int ph = 0;
#define RUN_PHASE (ph >= lo && ph < hi)
#define END_PHASE do { if (ph >= lo && ph + 1 < hi) { \
        if (ph == lo && hi > 4096) {   asm volatile("s_waitcnt vmcnt(0)" ::: "memory"); grid.sync(); __builtin_amdgcn_fence(__ATOMIC_ACQUIRE, "agent"); asm volatile("s_waitcnt vmcnt(0)" ::: "memory"); }   \
        else { PrmC pb_ = get_prm(); XcdBarrier xb_; xb_.bar = (unsigned*)(pb_->ws + OFF_BAR); xb_.x = xb_xcc_id(); xb_.st = (volatile LAS unsigned*)(LAS unsigned char*)(smem + LDS_BYTES - 16); xcd_barrier(xb_); } } ++ph; } while (0)

    if (RUN_PHASE) { PrmC p = get_prm(); phase_mod(p, smem); __syncthreads();
        PHASE_LOCALS int rot = 0;
        const int first_free = G > 176 ? 144 : 0, vb = bid() - first_free;
        if (vb >= 0) { const int gw2 = vb * 8 + wave, NGW2 = (G - first_free) * 8;
            convert_weights<1>(p->ffn_w_in, 1024, 5632, (bf16_t*)(p->ws + OFF_WFI), scr, gw2, NGW2, rot);
            convert_weights<0>(p->ffn_w_out, 2816, 1024, (bf16_t*)(p->ws + OFF_WFO), scr, gw2, NGW2, rot, 1408, (bf16_t*)(p->ws + OFF_WFOS));
            convert_weights<2>(p->ab_w_in, 1024, 3600, (bf16_t*)(p->ws + OFF_WMI), scr, gw2, NGW2, rot); } }
    END_PHASE;

#pragma unroll 1
    for (int l = 0; l < 4; ++l) {
        const bool is_ab = (l & 1) == 0; const int mi = l >> 1; const bool last = l == 3;
#pragma unroll 1
        for (int st = 0; st < 13; ++st) {
            if (st == 8 && !is_ab) continue;
            if (RUN_PHASE) {
#ifdef DUP_MASK
              for (int rep_ = 0; rep_ < (((DUP_MASK) >> st) & 1) + 1; ++rep_) {
                if (rep_) __syncthreads();
#endif
                PrmC p = get_prm();
                PHASE_LOCALS
                float* X = (float*)(p->ws + OFF_X); const float* MOD = (const float*)(p->ws + OFF_MOD); bf16_t* HY = (bf16_t*)(p->ws + OFF_HY);
                bf16_t* WFI = (bf16_t*)(p->ws + OFF_WFI); bf16_t* WFO = (bf16_t*)(p->ws + OFF_WFO); bf16_t* WMI = (bf16_t*)(p->ws + OFF_WMI); bf16_t* WMO = (bf16_t*)(p->ws + OFF_WMO);
                const int Mrows = (last && st >= 9) ? T_LAT : T_ALL;
                const bool x_from_input = (l == 0 && st <= 2);
                const float* xlat = x_from_input ? p->x : X; const float* xctx = (l == 0 && st <= 3) ? p->ctx : X + (size_t)T_LAT * 1024;
                if (st == 0 || st == 3 || st == 10) {
#ifdef PROBE_NORM
                  for (int rep_ = 0; rep_ < 2; ++rep_) {
#endif
                    int rot = 0;
                    const float* fixgate = st == 3 ? MOD + ((size_t)l * 9 + 8) * 9216 + 2 * 1024 : ((st == 0 && l > 0) ? MOD + ((size_t)(l - 1) * 9 + 8) * 9216 + 8 * 1024 : ((st == 10 && !last) ? MOD + ((size_t)l * 9 + 8) * 9216 + 5 * 1024 : nullptr));
                    norm_rows(p, xlat, xctx, l, st == 0 ? 0 : (st == 3 ? 1 : 2), Mrows, gw, NGW, rot, fixgate, st == 10 ? 1.0f : 0.5f);
#ifdef PROBE_NORM
                  }
#endif
                } else if (st == 1 || st == 11) {
                    pg8::Gemm g{HY, st == 1 ? WFI : (bf16_t*)(p->ws + OFF_WFI2), Mrows, 5632, 1024}; pg8::StaticOrder S; S.init(Mrows, 5632, G, bid());
                    pg8::EpiSwiglu E{(bf16_t*)(p->ws + OFF_HID), 2816, (bf16_t*)(p->ws + OFF_HIDC)};
                    pg8::gemm_phase<pg8::EpiSwiglu, pg8::StaticOrder, true, true>(lds, g, S, E);
                } else if (st == 2 || st == 9 || st == 12) {
                    const int sub = st == 2 ? 0 : (st == 9 ? 1 : 2);
                    const bf16_t* A = st == 9 ? HY : (const bf16_t*)(p->ws + OFF_HID);
                    const bf16_t* Bt = st == 9 ? WMO : (st == 2 ? WFO : (const bf16_t*)(p->ws + OFF_WFO2));
                    const int K = st == 9 ? (is_ab ? 1024 : 2048) : 2816;
                    const bool split = Mrows == T_ALL;
                    const int Mg = split ? T_LAT : Mrows;
                    pg8::Gemm g{A, Bt, Mg, 1024, K}; pg8::StaticOrder S; S.init(Mg, 1024, G, bid());
                    pg8::EpiResid E{xlat, xctx, X, MOD + (size_t)l * 9 * 9216 + (3 * sub + 2) * 1024, st == 9 ? 1.0f : 0.5f};
                    pg8::gemm_phase<pg8::EpiResid, pg8::StaticOrder, false, true>(lds, g, S, E);
                    if (split) {
                        const int Kh = K >> 1;
                        pg8::Gemm g2{st == 9 ? (const bf16_t*)HY + (size_t)T_LAT * K : (const bf16_t*)(p->ws + OFF_HIDC), (const bf16_t*)(p->ws + (st == 9 ? (is_ab ? OFF_WMOS_AB : OFF_WMOS_RET) : (st == 2 ? OFF_WFOS : OFF_WFOS2))), 4096, 2048, Kh}; pg8::CtxSplitOrder S2{G, bid()};
                        pg8::EpiPartial E2{(float*)(p->ws + OFF_PART)};
                        pg8::gemm_phase<pg8::EpiPartial, pg8::CtxSplitOrder, false, true>(lds, g2, S2, E2);
                    }
                    if (st == 2 || (st == 12 && !last)) {
                        const int first_idle = 64 % G, vb = bid() - first_idle;
                        if (vb >= 0) { const int gw2 = vb * 8 + wave, NGW2 = (G - first_idle) * 8; int rot = 0;
                            if (st == 2) {
                                convert_weights<1>(p->ffn_w_in + (size_t)(l * 2 + 1) * 1024 * 5632, 1024, 5632, (bf16_t*)(p->ws + OFF_WFI2), scr, gw2, NGW2, rot);
                                convert_weights<0>(p->ffn_w_out + (size_t)(l * 2 + 1) * 2816 * 1024, 2816, 1024, (bf16_t*)(p->ws + OFF_WFO2), scr, gw2, NGW2, rot, 1408, (bf16_t*)(p->ws + OFF_WFOS2));
                                if (is_ab) convert_weights<0>(p->ab_w_out + (size_t)mi * 1024 * 1024, 1024, 1024, WMO, scr, gw2, NGW2, rot, 512, (bf16_t*)(p->ws + OFF_WMOS_AB));
                                else convert_weights<0>(p->ret_w_out + (size_t)mi * 2048 * 1024, 2048, 1024, WMO, scr, gw2, NGW2, rot, 1024, last ? (bf16_t*)nullptr : (bf16_t*)(p->ws + OFF_WMOS_RET));
                            } else {
                                convert_weights<1>(p->ffn_w_in + (size_t)(l * 2 + 2) * 1024 * 5632, 1024, 5632, WFI, scr, gw2, NGW2, rot);
                                convert_weights<0>(p->ffn_w_out + (size_t)(l * 2 + 2) * 2816 * 1024, 2816, 1024, WFO, scr, gw2, NGW2, rot, 1408, (bf16_t*)(p->ws + OFF_WFOS));
                                if (!is_ab) convert_weights<2>(p->ab_w_in + (size_t)(mi + 1) * 1024 * 3600, 1024, 3600, WMI, scr, gw2, NGW2, rot);
                                else convert_weights<0>(p->ret_w_in + (size_t)mi * 1024 * 6144, 1024, 6144, WMI, scr, gw2, NGW2, rot);
                            } } }
                } else if (st == 4) {
                    const int N = is_ab ? 3840 : 6144;
                    pg8::Gemm g{HY, WMI, T_ALL, N, 1024}; pg8::StaticOrder S; S.init(T_ALL, N, G, bid());
                    pg8::EpiBf16 E{(bf16_t*)(p->ws + OFF_BIG), is_ab ? 3840 : 2048, is_ab ? 0 : 2048, is_ab ? (size_t)0 : RP_STRIDE};
                    pg8::gemm_phase<pg8::EpiBf16, pg8::StaticOrder, true, true>(lds, g, S, E);
                } else if (st == 5) {
                    PROBE_LOOP(PROBE_ST5) { if (is_ab) phase_ab_prep(p, mi, smem); else phase_ret_prep(p, mi, smem); }
                } else if (st == 6) {
                    PROBE_LOOP(PROBE_ST6) { if (is_ab) { const int extra = 576 % G;
                        (void)extra; phase_dn_chunkprep(p, smem, bid(), G); phase_attn(p, mi, l, 576, smem); }     else phase_ret_chunk(p, mi, smem, last); }
                } else if (st == 7) {
                    PROBE_LOOP(PROBE_ST7) { if (is_ab) phase_dn_chunkrec(p, smem); else phase_ret_merge(p, last ? T_LAT : T_ALL, gw, NGW); }
                } else if (st == 8) {
                    PROBE_LOOP(PROBE_ST8) { phase_dn_merge(p, mi, T_ALL, gw, NGW); }
                }
#ifdef DUP_MASK
              }
#endif
            }
            END_PHASE;
        }
        if (!is_ab) { ++ph; }
    }
    if (RUN_PHASE) { PrmC p = get_prm(); PHASE_LOCALS phase_final(p, gw, NGW); }
}

extern "C" void kernel_launch(void* const* d_in, const int* in_sizes, int n_in, void* d_out, int out_size, void* d_ws, size_t ws_size, hipStream_t stream) {
    static int grid_blocks = 0;
    if (grid_blocks == 0) {
        if (ws_size < WS_NEED) { fprintf(stderr, "kernel_launch: workspace too small: %zu < %zu\n", ws_size, (size_t)WS_NEED); grid_blocks = -1; return; }
        int dev = 0, cus = 0, per_cu = 0;
        hipGetDevice(&dev);
        hipDeviceGetAttribute(&cus, hipDeviceAttributeMultiprocessorCount, dev);
        if (hipFuncSetAttribute((const void*)fwd_megakernel, hipFuncAttributeMaxDynamicSharedMemorySize, LDS_BYTES) != hipSuccess) { fprintf(stderr, "kernel_launch: hipFuncSetAttribute failed\n"); grid_blocks = -1; return; }
        if (hipOccupancyMaxActiveBlocksPerMultiprocessor(&per_cu, (const void*)fwd_megakernel, NTHR, LDS_BYTES) != hipSuccess || per_cu < 1) { fprintf(stderr, "kernel_launch: occupancy query says %d\n", per_cu); per_cu = 1; (void)hipGetLastError(); }
        grid_blocks = cus * 1;
    }
    if (grid_blocks < 0) return;
    Prm p{};
    const float** pp = (const float**)&p;
    for (int i = 0; i < 21; ++i) pp[i] = (const float*)d_in[i];
    p.out = (float*)d_out; p.ws = (unsigned char*)d_ws;
    if (hipMemsetAsync((unsigned char*)d_ws + OFF_BAR, 0, SZ_BAR, stream) != hipSuccess) { fprintf(stderr, "kernel_launch: memset failed\n"); return; }
#if defined(MK_MULTI)
    for (int i = 0; i < N_PHASES; ++i) hipLaunchKernelGGL(fwd_megakernel, dim3(grid_blocks), dim3(NTHR), LDS_BYTES, stream, p, i, i + 1);
#else
    int lo = 0, hi = N_PHASES;
    void* args[] = {&p, &lo, &hi};
    hipError_t e = hipLaunchCooperativeKernel((const void*)fwd_megakernel, dim3(grid_blocks), dim3(NTHR), args, LDS_BYTES, stream);
    if (e != hipSuccess) fprintf(stderr, "cooperative launch failed: %s (grid %d)\n", hipGetErrorString(e), grid_blocks);
#endif
}
```
